# Optimizing an MI355X kernel written in HIP

```python
import math
import jax, jax.numpy as jnp
from jax import lax
import numpy as np

D_MODEL = 1024
BATCH = 8
SEQ = 4096
DEPTH = 2

SSM_HEADS = 16
SSM_HEAD_DIM = 64
SSM_INNER = SSM_HEADS * SSM_HEAD_DIM
SSM_GROUPS = 4
SSM_HEADS_PER_GROUP = SSM_HEADS // SSM_GROUPS
SSM_STATE = 128
SSM_CONV = 4
SSM_CHUNK = 128
SSM_CONV_DIM = SSM_INNER + 2 * SSM_GROUPS * SSM_STATE

ATTN_HEAD_DIM = 64
ATTN_SLOTS = 8
ATTN_PATTERNS = ((128, 1), (512, 4), (2048, 16))
ATTN_GROUPS = len(ATTN_PATTERNS)
ATTN_Q_WIDTH = ATTN_GROUPS * ATTN_SLOTS * ATTN_HEAD_DIM
ATTN_KV_WIDTH = ATTN_SLOTS * ATTN_HEAD_DIM
ATTN_BLOCK = 128

SC_WIDTH = 512
SC_CONV = 3

N_BRANCH = 3
NORM_EPS = 1e-6

SPLITS = (
    SSM_INNER,
    SSM_CONV_DIM,
    SSM_HEADS,
    ATTN_Q_WIDTH,
    ATTN_KV_WIDTH,
    ATTN_KV_WIDTH,
    ATTN_KV_WIDTH,
    SC_WIDTH,
    SC_WIDTH,
    SC_WIDTH,
    SC_WIDTH,
    N_BRANCH * D_MODEL,
)
IN_WIDTH = sum(SPLITS)
SPLIT_OFFSETS = tuple(int(o) for o in np.cumsum(SPLITS)[:-1])

kernel_name = "hybrid_ssd_dilated_attn_shortconv"


def rms_norm(x, w):
    xf = x.astype(jnp.float32)
    y = xf * lax.rsqrt(jnp.mean(xf * xf, axis=-1, keepdims=True) + NORM_EPS)
    return (y * w.astype(jnp.float32)).astype(x.dtype)


def causal_depthwise_conv(x, w):
    k_width = w.shape[0]
    return lax.conv_general_dilated(
        x, w[:, None, :].astype(x.dtype), window_strides=(1,),
        padding=((k_width - 1, 0),), dimension_numbers=("NWC", "WIO", "NWC"),
        feature_group_count=x.shape[-1])


def ssd_scan(xdt, a, b_in, c_in):
    bsz, s = xdt.shape[:2]
    n_chunks = s // SSM_CHUNK

    def chunks(t):
        return jnp.moveaxis(t.reshape(bsz, n_chunks, SSM_CHUNK, *t.shape[2:]), 1, 0)

    causal = jnp.tril(jnp.ones((SSM_CHUNK, SSM_CHUNK), dtype=bool))[None, :, :, None, None]

    def step(state, inp):
        xc, ac, bc, cc = inp
        cs = jnp.cumsum(ac, axis=1)
        seg = cs[:, :, None] - cs[:, None, :]
        lmat = jnp.exp(jnp.where(causal, seg, -jnp.inf))
        cb = jnp.einsum("blgn,bsgn->blsg", cc, bc)
        y_diag = jnp.einsum("blsg,blsgj,bsgjp->blgjp", cb, lmat, xc)
        y_off = jnp.einsum("blgn,bgjpn,blgj->blgjp", cc, state, jnp.exp(cs))
        decay = jnp.exp(cs[:, -1:] - cs)
        new_state = (state * jnp.exp(cs[:, -1])[..., None, None]
                     + jnp.einsum("blgn,blgj,blgjp->bgjpn", bc, decay, xc))
        return new_state, y_diag + y_off

    state0 = jnp.zeros((bsz, SSM_GROUPS, SSM_HEADS_PER_GROUP, SSM_HEAD_DIM, SSM_STATE), jnp.float32)
    _, ys = lax.scan(step, state0, (chunks(xdt), chunks(a), chunks(b_in), chunks(c_in)))
    return jnp.moveaxis(ys, 0, 1).reshape(xdt.shape)


def ssd_branch(z, xbc, dt_raw, conv_w, conv_b, dt_bias, a_log, d_skip, norm_w):
    bsz, s, _ = xbc.shape
    xbc = jax.nn.silu(causal_depthwise_conv(xbc, conv_w) + conv_b.astype(xbc.dtype))
    gn = SSM_GROUPS * SSM_STATE
    xs = xbc[..., :SSM_INNER].astype(jnp.float32).reshape(
        bsz, s, SSM_GROUPS, SSM_HEADS_PER_GROUP, SSM_HEAD_DIM)
    b_in = xbc[..., SSM_INNER:SSM_INNER + gn].astype(jnp.float32).reshape(bsz, s, SSM_GROUPS, SSM_STATE)
    c_in = xbc[..., SSM_INNER + gn:].astype(jnp.float32).reshape(bsz, s, SSM_GROUPS, SSM_STATE)
    dt = jax.nn.softplus(dt_raw.astype(jnp.float32) + dt_bias.astype(jnp.float32))
    dt = dt.reshape(bsz, s, SSM_GROUPS, SSM_HEADS_PER_GROUP)
    a_neg = -jnp.exp(a_log.astype(jnp.float32)).reshape(SSM_GROUPS, SSM_HEADS_PER_GROUP)
    y = ssd_scan(xs * dt[..., None], dt * a_neg, b_in, c_in)
    y = y + xs * d_skip.astype(jnp.float32).reshape(SSM_GROUPS, SSM_HEADS_PER_GROUP, 1)
    yg = y.reshape(bsz, s, SSM_INNER) * jax.nn.silu(z.astype(jnp.float32))
    yg = yg.reshape(bsz, s, SSM_GROUPS, SSM_INNER // SSM_GROUPS)
    yg = yg * lax.rsqrt(jnp.mean(yg * yg, axis=-1, keepdims=True) + NORM_EPS)
    yg = yg.reshape(bsz, s, SSM_INNER) * norm_w.astype(jnp.float32)
    return yg.astype(z.dtype)


def dilated_window_attention(q, k, v, window, dilation):
    bsz, s, h, dh = q.shape
    n_back = window // dilation
    length = s // dilation
    n_blocks = -(-length // ATTN_BLOCK)
    padded = n_blocks * ATTN_BLOCK

    def residues(t):
        return t.reshape(bsz, length, dilation, h, dh).transpose(0, 2, 1, 3, 4)

    qr = jnp.pad(residues(q), ((0, 0), (0, 0), (0, padded - length), (0, 0), (0, 0)))
    qb = qr.reshape(bsz, dilation, n_blocks, ATTN_BLOCK, h, dh)

    def key_blocks(t):
        tr = jnp.pad(residues(t), ((0, 0), (0, 0), (ATTN_BLOCK, padded - length), (0, 0), (0, 0)))
        tr = tr.reshape(bsz, dilation, n_blocks + 1, ATTN_BLOCK, h, dh)
        return jnp.concatenate([tr[:, :, :-1], tr[:, :, 1:]], axis=3)

    kb = key_blocks(k)
    vb = key_blocks(v)
    q_idx = jnp.arange(ATTN_BLOCK)[:, None] + ATTN_BLOCK
    k_idx = jnp.arange(2 * ATTN_BLOCK)[None, :]
    diff = q_idx - k_idx
    band = (diff >= 0) & (diff <= n_back)
    key_pos = jnp.arange(n_blocks)[:, None] * ATTN_BLOCK - ATTN_BLOCK + k_idx
    valid = band[None] & (key_pos >= 0)[:, None, :]

    scores = jnp.einsum("brnqhd,brnkhd->brnhqk", qb, kb) * (ATTN_HEAD_DIM ** -0.5)
    scores = jnp.where(valid[None, None, :, None], scores, -jnp.inf)
    m = jnp.max(scores, axis=-1, keepdims=True)
    p = jnp.exp(scores - m)
    den = jnp.sum(p, axis=-1)
    o = jnp.einsum("brnhqk,brnkhd->brnqhd", p, vb) / jnp.moveaxis(den, -1, -2)[..., None]
    lse = jnp.moveaxis(m[..., 0] + jnp.log(den), -1, -2)

    o = o.reshape(bsz, dilation, padded, h, dh)[:, :, :length]
    o = o.transpose(0, 2, 1, 3, 4).reshape(bsz, s, h, dh)
    lse = lse.reshape(bsz, dilation, padded, h)[:, :, :length]
    lse = lse.transpose(0, 2, 1, 3).reshape(bsz, s, h)
    return o, lse


def attention_branch(q, k, v):
    bsz, s, _ = q.shape
    qf = q.astype(jnp.float32).reshape(bsz, s, ATTN_GROUPS, ATTN_SLOTS, ATTN_HEAD_DIM)
    kf = k.astype(jnp.float32).reshape(bsz, s, ATTN_SLOTS, ATTN_HEAD_DIM)
    vf = v.astype(jnp.float32).reshape(bsz, s, ATTN_SLOTS, ATTN_HEAD_DIM)
    outs, lses = [], []
    for g, (window, dilation) in enumerate(ATTN_PATTERNS):
        o, lse = dilated_window_attention(qf[:, :, g], kf, vf, window, dilation)
        outs.append(o)
        lses.append(lse)
    weights = jax.nn.softmax(jnp.stack(lses, axis=0), axis=0)
    out = jnp.sum(weights[..., None] * jnp.stack(outs, axis=0), axis=0)
    return out.reshape(bsz, s, ATTN_KV_WIDTH).astype(q.dtype)


def hybrid_layer(x, norm_pre, norm_post, w_in, ssm_conv_w, ssm_conv_b, dt_bias, a_log,
                 d_skip, ssm_norm, sc_conv_w, p_ssm, p_attn, p_sc, w_out):
    bsz, s, _ = x.shape
    h = rms_norm(x, norm_pre)
    proj = h @ w_in.astype(h.dtype)
    (z, xbc, dt_raw, q, k, v, g_attn, u, b_sc, c_sc, g_sc, merge) = jnp.split(
        proj, SPLIT_OFFSETS, axis=-1)

    y_ssm = ssd_branch(z, xbc, dt_raw, ssm_conv_w, ssm_conv_b, dt_bias, a_log, d_skip, ssm_norm)
    y_attn = attention_branch(q, k, v) * jax.nn.silu(g_attn)
    y_sc = b_sc * causal_depthwise_conv(c_sc * u, sc_conv_w) * jax.nn.silu(g_sc)

    gates = jax.nn.sigmoid(merge.astype(jnp.float32)).reshape(bsz, s, N_BRANCH, D_MODEL)
    merged = (gates[:, :, 0] * (y_ssm @ p_ssm.astype(y_ssm.dtype)).astype(jnp.float32)
              + gates[:, :, 1] * (y_attn @ p_attn.astype(y_attn.dtype)).astype(jnp.float32)
              + gates[:, :, 2] * (y_sc @ p_sc.astype(y_sc.dtype)).astype(jnp.float32))
    out = merged.astype(x.dtype) @ w_out.astype(x.dtype)
    return x + rms_norm(out, norm_post)


def setup_inputs(seed: int = 0) -> dict:
    key = jax.random.key(seed)
    ks = jax.random.split(key, 16)

    def nrm(k, shape, scale):
        return jax.random.normal(k, shape, jnp.float32) * scale

    x = nrm(ks[0], (BATCH, SEQ, D_MODEL), 1.0)
    norm_pre = 1.0 + nrm(ks[1], (DEPTH, D_MODEL), 0.05)
    norm_post = 1.0 + nrm(ks[2], (DEPTH, D_MODEL), 0.05)
    w_in = nrm(ks[3], (DEPTH, D_MODEL, IN_WIDTH), D_MODEL ** -0.5)
    ssm_conv_w = nrm(ks[4], (DEPTH, SSM_CONV, SSM_CONV_DIM), SSM_CONV ** -0.5)
    ssm_conv_b = nrm(ks[5], (DEPTH, SSM_CONV_DIM), 0.01)
    dt0 = jnp.exp(jax.random.uniform(ks[6], (DEPTH, SSM_HEADS), jnp.float32,
                                     math.log(1e-3), math.log(1e-1)))
    dt_bias = dt0 + jnp.log(-jnp.expm1(-dt0))
    a_log = jnp.log(jax.random.uniform(ks[7], (DEPTH, SSM_HEADS), jnp.float32, 1.0, 16.0))
    d_skip = 1.0 + nrm(ks[8], (DEPTH, SSM_HEADS), 0.05)
    ssm_norm = 1.0 + nrm(ks[9], (DEPTH, SSM_INNER), 0.05)
    sc_conv_w = nrm(ks[10], (DEPTH, SC_CONV, SC_WIDTH), SC_CONV ** -0.5)
    p_ssm = nrm(ks[11], (DEPTH, SSM_INNER, D_MODEL), SSM_INNER ** -0.5)
    p_attn = nrm(ks[12], (DEPTH, ATTN_KV_WIDTH, D_MODEL), ATTN_KV_WIDTH ** -0.5)
    p_sc = nrm(ks[13], (DEPTH, SC_WIDTH, D_MODEL), SC_WIDTH ** -0.5)
    w_out = nrm(ks[14], (DEPTH, D_MODEL, D_MODEL), D_MODEL ** -0.5)
    return {"x": x, "norm_pre": norm_pre, "norm_post": norm_post, "w_in": w_in,
            "ssm_conv_w": ssm_conv_w, "ssm_conv_b": ssm_conv_b, "dt_bias": dt_bias,
            "a_log": a_log, "d_skip": d_skip, "ssm_norm": ssm_norm, "sc_conv_w": sc_conv_w,
            "p_ssm": p_ssm, "p_attn": p_attn, "p_sc": p_sc, "w_out": w_out}


def reference(x, norm_pre, norm_post, w_in, ssm_conv_w, ssm_conv_b, dt_bias, a_log,
              d_skip, ssm_norm, sc_conv_w, p_ssm, p_attn, p_sc, w_out):
    for i in range(DEPTH):
        x = hybrid_layer(x, norm_pre[i], norm_post[i], w_in[i], ssm_conv_w[i], ssm_conv_b[i],
                         dt_bias[i], a_log[i], d_skip[i], ssm_norm[i], sc_conv_w[i],
                         p_ssm[i], p_attn[i], p_sc[i], w_out[i])
    return x
```

```cpp
#include <hip/hip_runtime.h>
#include <hip/hip_cooperative_groups.h>
#include <cstdio>
#include <cstdint>
namespace cg = cooperative_groups;

#ifndef COOP
#define COOP 1
#endif

typedef unsigned short u16;
typedef unsigned int u32;
using bf16x8 = __attribute__((ext_vector_type(8))) short;
using f32x4 = __attribute__((ext_vector_type(4))) float;
using f32x16 = __attribute__((ext_vector_type(16))) float;
using U4 = __attribute__((ext_vector_type(4))) unsigned int;
using U2 = __attribute__((ext_vector_type(2))) unsigned int;

constexpr int D_ = 1024, S_ = 4096, NBATCH = 8, T_ = NBATCH * S_;
constexpr int NB = 2, TC = NB * S_, NCH = NBATCH / NB;
constexpr int NP = 11520;
constexpr int NORIG = 11280;
constexpr int CZ = 0, CX = 1024, CQ = 3072, CK = 4608, CV = 5120, CGA = 5632, CU = 6144, CBS = 6656,
              CCS = 7168, CGS = 7680, CM = 8192, CDT = 11264;
constexpr int NR1 = 768;
constexpr int HSMEM = 73728;
constexpr int SMEM_BYTES = 2 * HSMEM;
constexpr float EPS = 1e-6f;
__host__ __device__ __forceinline__ size_t paddr(size_t row, int col) {
  return ((((row >> 8) * (size_t)(NP / 256) + (size_t)(col >> 8)) * 16 + ((row >> 4) & 15)) * 4 + (size_t)((col >> 6) & 3)) * 1024 +
         (row & 15) * 64 + (size_t)(col & 63);
}

struct Params {
  const float *x, *norm_pre, *norm_post, *w_in, *ssm_conv_w, *ssm_conv_b, *dt_bias, *a_log, *d_skip,
      *ssm_norm, *sc_conv_w, *p_ssm, *p_attn, *p_sc, *w_out;
  float* out;
  u16 *WinT, *PsT, *PaT, *PcT, *WoT;
  u16 *h, *proj, *xc, *xT, *prev, *og, *yattn, *ysc, *yssm, *Pa, *Pb;
  float *dec, *lse;
  u16 *stloc, *outA, *outB;
  unsigned* bar;
};

__device__ __forceinline__ u32 pack2(float a, float b);
__device__ __forceinline__ int otid512() { int t = threadIdx.x; asm volatile("" : "+v"(t)); return t; }
__device__ __forceinline__ int otid() { return otid512() & 255; }
__device__ __forceinline__ u32 cvt_pk_bf16(float lo, float hi) { return pack2(lo, hi); }
__device__ __forceinline__ u16 f2bf(float f) {
  u32 u = __float_as_uint(f);
  u += 0x7fffu + ((u >> 16) & 1u);
  return (u16)(u >> 16);
}
__device__ __forceinline__ float bf2f(u16 h) { return __uint_as_float(((u32)h) << 16); }
__device__ __forceinline__ u32 pack2(float a, float b);
typedef float f32x2_t __attribute__((ext_vector_type(2)));
typedef __bf16 bf16x2_t __attribute__((ext_vector_type(2)));
__device__ __forceinline__ u32 pack2(float a, float b) { f32x2_t v = {a, b}; return __builtin_bit_cast(u32, __builtin_convertvector(v, bf16x2_t)); }
__device__ __forceinline__ float lo2f(u32 v) { return __uint_as_float(v << 16); }
__device__ __forceinline__ float hi2f(u32 v) { return __uint_as_float(v & 0xffff0000u); }
__device__ __forceinline__ float silu_f(float x) { return x * __builtin_amdgcn_rcpf(1.f + __expf(-x)); }
__device__ __forceinline__ float sigmoid_f(float x) { return __builtin_amdgcn_rcpf(1.f + __expf(-x)); }
__device__ __forceinline__ float softplus_f(float x) { const float e = __expf(x); return x > 20.f ? x : (e < 1e-4f ? e : __logf(1.f + e)); }
__device__ __forceinline__ float wave_sum(float v) {
#pragma unroll
  for (int o = 32; o > 0; o >>= 1) v += __shfl_xor(v, o, 64);
  return v;
}
__device__ __forceinline__ void unpack8(U4 v, float* f) {
  f[0] = lo2f(v.x); f[1] = hi2f(v.x); f[2] = lo2f(v.y); f[3] = hi2f(v.y);
  f[4] = lo2f(v.z); f[5] = hi2f(v.z); f[6] = lo2f(v.w); f[7] = hi2f(v.w);
}
__device__ __forceinline__ U4 pack8(const float* f) {
  U4 v; v.x = pack2(f[0], f[1]); v.y = pack2(f[2], f[3]); v.z = pack2(f[4], f[5]); v.w = pack2(f[6], f[7]);
  return v;
}
__device__ __forceinline__ f32x16 mfma32(bf16x8 a, bf16x8 b, f32x16 c) {
  return __builtin_amdgcn_mfma_f32_32x32x16_bf16(a, b, c, 0, 0, 0);
}
__device__ __forceinline__ f32x4 mfma16(bf16x8 a, bf16x8 b, f32x4 c) {
  return __builtin_amdgcn_mfma_f32_16x16x32_bf16(a, b, c, 0, 0, 0);
}
__device__ __forceinline__ bf16x8 as_bf16x8(U4 v) {
  return __builtin_bit_cast(bf16x8, v);
}
__device__ __forceinline__ bf16x8 ld_frag(const u16* p) { return as_bf16x8(*(const U4*)p); }

__device__ void transpose_tile(const float* __restrict__ src, int ld_src, u16* __restrict__ dst, int K, int n0,
                               int k0, int mapmode, const float* __restrict__ scale, char* smem) {
  float* tile = (float*)smem;
  const int tid = otid();
  const int nl = tid & 63;
  int n = n0 + nl;
  int col;
  if (mapmode == 0) col = n;
  else {
    if (n < 3072) col = n;
    else if (n < CDT) col = n + 16;
    else if (n < CDT + 16) col = 3072 + (n - CDT);
    else col = -1;
  }
  float v[32];
#pragma unroll
  for (int i = 0; i < 32; ++i) {
    int kk = (tid >> 6) + 4 * i;
    v[i] = (col >= 0) ? src[(size_t)(k0 + kk) * ld_src + col] : 0.f;
  }
  if (scale) {
#pragma unroll
    for (int i = 0; i < 32; ++i) v[i] *= scale[k0 + (tid >> 6) + 4 * i];
  }
#pragma unroll
  for (int i = 0; i < 32; ++i) tile[((tid >> 6) + 4 * i) * 65 + nl] = v[i];
  __syncthreads();
  {
    int nn = tid >> 2, kq = (tid & 3) * 32;
    u16* d = dst + (size_t)(n0 + nn) * K + k0 + kq;
#pragma unroll
    for (int h = 0; h < 4; ++h) {
      float f[8];
#pragma unroll
      for (int e = 0; e < 8; ++e) f[e] = tile[(kq + h * 8 + e) * 65 + nn];
      *(U4*)(d + h * 8) = pack8(f);
    }
  }
  __syncthreads();
}

__device__ void phase_weights(const Params& p, char* smem) {
  constexpr int NT_IN = (NP / 64) * 8, NT_PS = 128, NT_PA = 64, NT_PC = 64, NT_WO = 128;
  constexpr int PER_LAYER = NT_IN + NT_PS + NT_PA + NT_PC + NT_WO;
  const int half_ = __builtin_amdgcn_readfirstlane(otid512() >> 8);
  smem += half_ * HSMEM;
  for (int slot = blockIdx.x; slot < PER_LAYER; slot += gridDim.x) {
    int it = 2 * slot + half_;
    int l = it / PER_LAYER, r = it % PER_LAYER;
    if (r < NT_IN) {
      int nt = r / 8, kt = r % 8;
      transpose_tile(p.w_in + (size_t)l * D_ * NORIG, NORIG, p.WinT + (size_t)l * NP * D_, D_, nt * 64, kt * 128, 1,
                     p.norm_pre + l * D_, smem);
    } else if ((r -= NT_IN) < NT_PS) {
      int nt = r / 8, kt = r % 8;
      transpose_tile(p.p_ssm + (size_t)l * 1024 * 1024, 1024, p.PsT + (size_t)l * 1024 * 1024, 1024, nt * 64,
                     kt * 128, 0, nullptr, smem);
    } else if ((r -= NT_PS) < NT_PA) {
      int nt = r / 4, kt = r % 4;
      transpose_tile(p.p_attn + (size_t)l * 512 * 1024, 1024, p.PaT + (size_t)l * 1024 * 512, 512, nt * 64, kt * 128,
                     0, nullptr, smem);
    } else if ((r -= NT_PA) < NT_PC) {
      int nt = r / 4, kt = r % 4;
      transpose_tile(p.p_sc + (size_t)l * 512 * 1024, 1024, p.PcT + (size_t)l * 1024 * 512, 512, nt * 64, kt * 128, 0,
                     nullptr, smem);
    } else {
      r -= NT_PC;
      int nt = r / 8, kt = r % 8;
      transpose_tile(p.w_out + (size_t)l * 1024 * 1024, 1024, p.WoT + (size_t)l * 1024 * 1024, 1024, nt * 64,
                     kt * 128, 0, nullptr, smem);
    }
  }
  const int t512 = otid512();
  const int lane = t512 & 63, w = t512 >> 6;
  for (int it = blockIdx.x; it < T_ / 16; it += gridDim.x) {
    const int row = it * 16 + w * 2;
    const f32x4* xr = (const f32x4*)(p.x + (size_t)row * D_);
    f32x4 v[2][4];
    float ss0 = 0.f, ss1 = 0.f;
#pragma unroll
    for (int i = 0; i < 4; ++i) { v[0][i] = xr[i * 64 + lane]; v[1][i] = xr[256 + i * 64 + lane]; }
#pragma unroll
    for (int i = 0; i < 4; ++i) {
      ss0 += v[0][i].x * v[0][i].x + v[0][i].y * v[0][i].y + v[0][i].z * v[0][i].z + v[0][i].w * v[0][i].w;
      ss1 += v[1][i].x * v[1][i].x + v[1][i].y * v[1][i].y + v[1][i].z * v[1][i].z + v[1][i].w * v[1][i].w;
    }
    ss0 = wave_sum(ss0); ss1 = wave_sum(ss1);
    const float r0 = rsqrtf(ss0 * (1.f / D_) + EPS), r1 = rsqrtf(ss1 * (1.f / D_) + EPS);
#pragma unroll
    for (int i = 0; i < 4; ++i) {
      U2 o;
      o.x = pack2(v[0][i].x * r0, v[0][i].y * r0); o.y = pack2(v[0][i].z * r0, v[0][i].w * r0);
      *(U2*)(p.h + (size_t)row * D_ + (i * 64 + lane) * 4) = o;
      o.x = pack2(v[1][i].x * r1, v[1][i].y * r1); o.y = pack2(v[1][i].z * r1, v[1][i].w * r1);
      *(U2*)(p.h + (size_t)(row + 1) * D_ + (i * 64 + lane) * 4) = o;
    }
  }
}

#define LAS __attribute__((address_space(3)))
__device__ __forceinline__ int g_lds_byte(int r, int c) { const int st = (r >> 4) * 2 + (c >> 5), rr = r & 15, cc = c & 31, ob = rr * 64 + cc * 2; return st * 1024 + (ob ^ (((ob >> 9) & 1) << 5)); }
__device__ __forceinline__ void g_stage_rc(int b, int& R, int& C) { const int st = b / 1024, sb = b % 1024, swz = sb ^ (((sb >> 9) & 1) << 5); R = (st >> 1) * 16 + swz / 64; C = (st & 1) * 32 + (swz % 64) / 2; }
__device__ __forceinline__ void gemm_tile(const u16* __restrict__ A, int lda, const u16* __restrict__ Bt, int ldb,
                                          int K, f32x4 (&acc)[4][4], char* smem) {
  const int tid = otid(), lane = tid & 63, w = __builtin_amdgcn_readfirstlane(tid >> 6), wr = w >> 1, wc = w & 1;
  LAS unsigned char* lds = (LAS unsigned char*)smem;
  unsigned voA[4], voB[4];
#pragma unroll
  for (int i = 0; i < 4; ++i) {
    int R, C;
    g_stage_rc(tid * 16 + i * 4096, R, C);
    voA[i] = (unsigned)(R * lda + C) * 2u;
    voB[i] = (unsigned)(R * ldb + C) * 2u;
  }
  const unsigned ldsw = (unsigned)w * 1024u;
  const int fr = lane & 15, fq = lane >> 4;
  const int aoff = g_lds_byte(wr * 64 + fr, fq * 8), boff = g_lds_byte(wc * 64 + fr, fq * 8);
  const int nk = K / 64;
#define G_STAGE(buf, k0) do { _Pragma("unroll") for (int _i = 0; _i < 4; ++_i) { \
    __builtin_amdgcn_global_load_lds((const unsigned*)((const char*)A + (size_t)(k0) * 2 + voA[_i]), (LAS unsigned*)(lds + (buf) * 16384 + ldsw + _i * 4096), 16, 0, 0); \
    __builtin_amdgcn_global_load_lds((const unsigned*)((const char*)Bt + (size_t)(k0) * 2 + voB[_i]), (LAS unsigned*)(lds + 32768 + (buf) * 16384 + ldsw + _i * 4096), 16, 0, 0); } } while (0)
  G_STAGE(0, 0);
  for (int kt = 0; kt < nk; ++kt) {
    const int buf = kt & 1;
    asm volatile("s_waitcnt vmcnt(0)" ::: "memory");
    __syncthreads();
    if (kt + 1 < nk) {
      if (buf) G_STAGE(0, (kt + 1) * 64); else G_STAGE(1, (kt + 1) * 64);
    }
    const LAS unsigned char* as = lds + buf * 16384 + aoff;
    const LAS unsigned char* bs = lds + 32768 + buf * 16384 + boff;
#pragma unroll
    for (int ks = 0; ks < 2; ++ks) {
      bf16x8 af[4], bf[4];
#pragma unroll
      for (int mt = 0; mt < 4; ++mt) af[mt] = *(const LAS bf16x8*)(as + mt * 2048 + ks * 1024);
#pragma unroll
      for (int nt = 0; nt < 4; ++nt) bf[nt] = *(const LAS bf16x8*)(bs + nt * 2048 + ks * 1024);
#pragma unroll
      for (int mt = 0; mt < 4; ++mt)
#pragma unroll
        for (int nt = 0; nt < 4; ++nt) acc[mt][nt] = mfma16(bf[nt], af[mt], acc[mt][nt]);
    }
  }
#undef G_STAGE
  __syncthreads();
}

__device__ __forceinline__ void gemm_tile8(const u16* __restrict__ A, int lda, const u16* __restrict__ Bt, int ldb,
                                           int K, f32x4 (&acc)[4][4], char* smem) {
  const int tid = otid512(), lane = tid & 63, w = __builtin_amdgcn_readfirstlane(tid >> 6), wr = w >> 1, wc = w & 1;
  LAS unsigned char* lds = (LAS unsigned char*)smem;
  unsigned voA[2], voB[2];
#pragma unroll
  for (int i = 0; i < 2; ++i) {
    const int b = tid * 16 + i * 8192;
    const int R = b >> 7, cl = (b >> 4) & 7, C = (cl ^ (R & 7)) * 8;
    const int Rb = (R & 64) + ((R >> 2) & 3) * 16 + ((R >> 4) & 3) * 4 + (R & 3);
    voA[i] = (unsigned)(R * lda + C) * 2u;
    voB[i] = (unsigned)(Rb * ldb + C) * 2u;
  }
  const size_t a1step = (size_t)128 * lda * 2;
  const unsigned ldsw = (unsigned)w * 1024u;
  const int fr = lane & 15, fq = lane >> 4;
  const int arow = (wr >> 1) * 16384 + ((wr & 1) * 64 + fr) * 128;
  const int brow = 32768 + (wc * 64 + fr) * 128;
  const int ck0 = ((fq ^ (fr & 7)) << 4), ck1 = (((4 + fq) ^ (fr & 7)) << 4);
  const int nk = K / 64;
#define G8_STAGE(sb, k0) do { _Pragma("unroll") for (int _i = 0; _i < 2; ++_i) { \
    __builtin_amdgcn_global_load_lds((const unsigned*)((const char*)A + (size_t)(k0) * 2 + voA[_i]), (LAS unsigned*)(lds + (sb) + ldsw + _i * 8192), 16, 0, 0); \
    __builtin_amdgcn_global_load_lds((const unsigned*)((const char*)A + a1step + (size_t)(k0) * 2 + voA[_i]), (LAS unsigned*)(lds + (sb) + 16384 + ldsw + _i * 8192), 16, 0, 0); \
    __builtin_amdgcn_global_load_lds((const unsigned*)((const char*)Bt + (size_t)(k0) * 2 + voB[_i]), (LAS unsigned*)(lds + (sb) + 32768 + ldsw + _i * 8192), 16, 0, 0); } } while (0)
#define G8_COMPUTE(sb) do { \
    const LAS unsigned char* as_ = lds + (sb) + arow; const LAS unsigned char* bs_ = lds + (sb) + brow; \
    _Pragma("unroll") for (int ks = 0; ks < 2; ++ks) { \
      const int ck = ks ? ck1 : ck0; \
      bf16x8 af[4], bf[4]; \
      _Pragma("unroll") for (int mt = 0; mt < 4; ++mt) af[mt] = *(const LAS bf16x8*)(as_ + mt * 2048 + ck); \
      _Pragma("unroll") for (int nt = 0; nt < 4; ++nt) bf[nt] = *(const LAS bf16x8*)(bs_ + nt * 2048 + ck); \
      __builtin_amdgcn_s_setprio(1); \
      _Pragma("unroll") for (int mt = 0; mt < 4; ++mt) _Pragma("unroll") for (int nt = 0; nt < 4; ++nt) acc[mt][nt] = mfma16(bf[nt], af[mt], acc[mt][nt]); \
      __builtin_amdgcn_s_setprio(0); } } while (0)
  G8_STAGE(0, 0); G8_STAGE(49152, 64);
  int cur = 0, nxt2 = 2 * 49152;
  for (int kt = 0; kt < nk - 1; ++kt) {
    asm volatile("s_waitcnt vmcnt(6)" ::: "memory");
    __builtin_amdgcn_s_barrier();
    asm volatile("" ::: "memory");
    if (kt + 2 < nk) G8_STAGE(nxt2, (kt + 2) * 64);
    G8_COMPUTE(cur);
    cur = (cur == 2 * 49152) ? 0 : cur + 49152;
    nxt2 = (nxt2 == 2 * 49152) ? 0 : nxt2 + 49152;
  }
  asm volatile("s_waitcnt vmcnt(0)" ::: "memory");
  __builtin_amdgcn_s_barrier();
  asm volatile("" ::: "memory");
  G8_COMPUTE(cur);
#undef G8_STAGE
#undef G8_COMPUTE
  __syncthreads();
}

__device__ __forceinline__ void zero_acc(f32x4 (&acc)[4][4]) {
#pragma unroll
  for (int a = 0; a < 4; ++a)
#pragma unroll
    for (int b = 0; b < 4; ++b) acc[a][b] = f32x4{0.f, 0.f, 0.f, 0.f};
}

namespace pg8 {
constexpr int BM = 256, BK = 64, HALF = 128, HTB = HALF * BK * 2, NXCD = 8, WGM = 8;
__device__ __forceinline__ int lds_byte(int r, int c) { const int st = (r >> 4) * 2 + (c >> 5), rr = r & 15, cc = c & 31, ob = rr * 64 + cc * 2; return st * 1024 + (ob ^ (((ob >> 9) & 1) << 5)); }
__device__ __forceinline__ void stage_rc(int b, int& R, int& C) { const int st = b / 1024, sb = b % 1024, swz = sb ^ (((sb >> 9) & 1) << 5); R = (st >> 1) * 16 + swz / 64; C = (st & 1) * 32 + (swz % 64) / 2; }
__device__ __forceinline__ int perm32(int rho) { const int n = rho >> 4, i = rho & 15; return 8 * (i >> 2) + 4 * n + (i & 3); }
struct Unit { int pm, pn; const char* a; const char* b; int mode; int gcol; };
struct StaticOrder {
  int nM, nN, nwg, G, c;
  __device__ void init(int M, int N, int G_, int c_) { nM = M / BM; nN = N / BM; nwg = nM * nN; G = G_; c = c_; }
  __device__ bool next(int i, int& pm, int& pn) const {
    const long L = (long)i * G + c; if (L >= nwg) return false;
    int wgid = (int)L; { const int q = nwg / NXCD, r = nwg % NXCD, xcd = wgid % NXCD, off = wgid / NXCD; wgid = (xcd < r ? xcd * (q + 1) : r * (q + 1) + (xcd - r) * q) + off; }
    const int nig = WGM * nN, gid = wgid / nig, fm = gid * WGM, gsz = (nM - fm) < WGM ? (nM - fm) : WGM;
    pm = fm + ((wgid % nig) % gsz); pn = (wgid % nig) / gsz; return true;
  }
};
struct Sched {
  int kind; StaticOrder so; const char* gA; const char* gB; size_t tstep; int mode0;
  int n; Unit u0, u1;
  __device__ __forceinline__ bool next(int i, Unit& u) const {
    if (kind == 0) {
      int pm, pn; if (!so.next(i, pm, pn)) return false;
      u.pm = pm; u.pn = pn; u.a = gA + (size_t)pm * tstep; u.b = gB + (size_t)pn * tstep; u.mode = mode0; u.gcol = 0; return true;
    }
    if (i >= n) return false;
    u = (i == 0) ? u0 : u1; return true;
  }
};
struct Epi {
  u16* O16; int ld16; u16* T16; int ldt; const u16* gate; int ldg;
  __device__ __forceinline__ void operator()(const f32x4 (&acc)[2][2][4][2], const Unit& u, int wr, int wc, int fr, int fq) const {
    const int row0 = u.pm * BM + wr * 64 + fr, col0 = u.pn * BM + wc * 64 + 16 * fq;
    const int mode = u.mode;
    if (mode == 5) return;
#pragma unroll
    for (int ai = 0; ai < 2; ++ai)
#pragma unroll
      for (int m = 0; m < 4; ++m) {
        const size_t row = (size_t)(row0 + ai * HALF + m * 16);
#pragma unroll
        for (int bj = 0; bj < 2; ++bj) {
          f32x4 v0 = acc[ai][bj][m][0], v1 = acc[ai][bj][m][1];
          const int col = col0 + bj * 8;
          if (mode != 0) {
            U4 gv = *(const U4*)(gate + row * ldg + u.gcol + col);
            float g8[8];
            unpack8(gv, g8);
            v0[0] *= sigmoid_f(g8[0]); v0[1] *= sigmoid_f(g8[1]); v0[2] *= sigmoid_f(g8[2]); v0[3] *= sigmoid_f(g8[3]);
            v1[0] *= sigmoid_f(g8[4]); v1[1] *= sigmoid_f(g8[5]); v1[2] *= sigmoid_f(g8[6]); v1[3] *= sigmoid_f(g8[7]);
            if (mode == 3) {
              float t8[8];
              unpack8(*(const U4*)(T16 + row * ldt + col), t8);
              v0[0] += t8[0]; v0[1] += t8[1]; v0[2] += t8[2]; v0[3] += t8[3];
              v1[0] += t8[4]; v1[1] += t8[5]; v1[2] += t8[6]; v1[3] += t8[7];
            }
          }
          U4 w; w.x = cvt_pk_bf16(v0[0], v0[1]); w.y = cvt_pk_bf16(v0[2], v0[3]); w.z = cvt_pk_bf16(v1[0], v1[1]); w.w = cvt_pk_bf16(v1[2], v1[3]);
          u16* dst = (mode == 2) ? (T16 + row * ldt + col) : (O16 + paddr(row, col));
#ifdef NT_STORE
          __builtin_nontemporal_store(w, (U4*)dst);
#else
          *(U4*)dst = w;
#endif
        }
      }
  }
};
__device__ __forceinline__ void gemm_phase(LAS unsigned char* lds, int K, const Sched& S, const Epi& E) {
  const int tid = otid512(), wid = __builtin_amdgcn_readfirstlane(tid >> 6), lane = tid & 63, wr = wid >> 2, wc = wid & 3, fr = lane & 15, fq = lane >> 4;
  const int nt = K / BK;
  unsigned voffA[2], voffB[2];
#pragma unroll
  for (int i = 0; i < 2; ++i) {
    const int b_ = tid * 16 + i * 8192; const int R = b_ >> 7; const int C = ((((b_ >> 4) & 7) ^ (R & 7)) * 8);
    const int Rb = (R >> 5) * 64 + ((R >> 2) & 3) * 16 + ((R >> 4) & 1) * 4 + (R & 3);
    voffA[i] = (unsigned)(R * K + C) * 2u; voffB[i] = (unsigned)(Rb * K + C) * 2u; }
  const size_t kstep = (size_t)(BK * 2);
  const size_t hstep = (size_t)HALF * K * 2;
  const size_t hstepB = (size_t)8 * K * 2;
  const unsigned ldsw = (unsigned)wid * 1024u;
  const int aoff = (wr * 64 + fr) * 128, boff = (wc * 32 + fr) * 128;
  const int ck0 = ((fq ^ (fr & 7)) << 4), ck1 = (((4 + fq) ^ (fr & 7)) << 4);
#define PG8_SA(b, h) (((b) * 2 + (h)) * HTB)
#define PG8_SB(b, h) ((4 + (b) * 2 + (h)) * HTB)
#define PG8_STAGE(bufoff, gbase, voff) do { _Pragma("unroll") for (int _i = 0; _i < 2; ++_i) \
    __builtin_amdgcn_global_load_lds((const unsigned*)((const char*)(gbase) + (voff)[_i]), (LAS unsigned*)(lds + (bufoff) + ldsw + _i * 8192), 16, 0, 0); } while (0)
#define PG8_LDA(dst, b, h) do { _Pragma("unroll") for (int m = 0; m < 4; ++m) _Pragma("unroll") for (int k = 0; k < 2; ++k) dst[m][k] = *(const LAS bf16x8*)(lds + PG8_SA(b, h) + aoff + m * 2048 + (k ? ck1 : ck0)); } while (0)
#define PG8_LDB(dst, b, h) do { _Pragma("unroll") for (int n = 0; n < 2; ++n) _Pragma("unroll") for (int k = 0; k < 2; ++k) dst[n][k] = *(const LAS bf16x8*)(lds + PG8_SB(b, h) + boff + n * 2048 + (k ? ck1 : ck0)); } while (0)
#define PG8_MMA(ai, bj, At, Bt) do { __builtin_amdgcn_s_setprio(1); _Pragma("unroll") for (int m = 0; m < 4; ++m) _Pragma("unroll") for (int n = 0; n < 2; ++n) _Pragma("unroll") for (int k = 0; k < 2; ++k) \
    acc[ai][bj][m][n] = __builtin_amdgcn_mfma_f32_16x16x32_bf16(Bt[n][k], At[m][k], acc[ai][bj][m][n], 0, 0, 0); __builtin_amdgcn_s_setprio(0); } while (0)
#define PG8_WAIT_V(n) asm volatile("s_waitcnt vmcnt(" #n ")" ::: "memory")
#define PG8_WAIT_L(n) asm volatile("s_waitcnt lgkmcnt(" #n ")" ::: "memory")
#define PG8_BAR __builtin_amdgcn_s_barrier()
#define PG8_SCHED __builtin_amdgcn_sched_barrier(0)
  Unit cur, nxt; int ui = 0;
  if (!S.next(0, cur)) return;
  f32x4 acc[2][2][4][2];
#pragma unroll
  for (int a = 0; a < 2; ++a)
#pragma unroll
    for (int b = 0; b < 2; ++b)
#pragma unroll
      for (int m = 0; m < 4; ++m)
#pragma unroll
        for (int n = 0; n < 2; ++n) acc[a][b][m][n] = (f32x4){0.f, 0.f, 0.f, 0.f};
  bf16x8 At[4][2], B0[2][2], B1[2][2];
  const char* cA = cur.a; const char* cB = cur.b;
  PG8_STAGE(PG8_SB(0, 0), cB, voffB); PG8_STAGE(PG8_SA(0, 0), cA, voffA); PG8_STAGE(PG8_SB(0, 1), cB + hstepB, voffB); PG8_STAGE(PG8_SA(0, 1), cA + hstep, voffA);
  if (wr == 1) PG8_BAR;
  PG8_WAIT_V(4); PG8_BAR;
  PG8_STAGE(PG8_SB(1, 0), cB + kstep, voffB); PG8_STAGE(PG8_SA(1, 0), cA + kstep, voffA); PG8_STAGE(PG8_SB(1, 1), cB + hstepB + kstep, voffB);
  PG8_WAIT_V(6); PG8_BAR;
  for (;;) {
    const bool has_next = S.next(ui + 1, nxt);
    const char* nA = has_next ? nxt.a : cA; const char* nB = has_next ? nxt.b : cB;
    for (int t = 0; t < nt; t += 2) {
      const bool last = (t == nt - 2);
      const char* a1 = cA + (size_t)(t + 1) * kstep;
      const char* a2 = last ? nA : cA + (size_t)(t + 2) * kstep; const char* b2 = last ? nB : cB + (size_t)(t + 2) * kstep;
      const char* a3 = a2 + kstep; const char* b3 = b2 + kstep;
      PG8_LDB(B0, 0, 0); PG8_SCHED; PG8_LDA(At, 0, 0); PG8_STAGE(PG8_SA(1, 1), a1 + hstep, voffA);
      PG8_WAIT_L(8); PG8_BAR; PG8_WAIT_L(0); PG8_MMA(0, 0, At, B0); PG8_BAR; PG8_SCHED;
      PG8_LDB(B1, 0, 1); PG8_STAGE(PG8_SB(0, 0), b2, voffB);
      PG8_BAR; PG8_WAIT_L(0); PG8_MMA(0, 1, At, B1); PG8_BAR;
      PG8_LDA(At, 0, 1); PG8_STAGE(PG8_SA(0, 0), a2, voffA);
      PG8_BAR; PG8_WAIT_L(0); PG8_MMA(1, 0, At, B0); PG8_BAR; PG8_SCHED;
      PG8_STAGE(PG8_SB(0, 1), b2 + hstepB, voffB);
      PG8_WAIT_V(6); PG8_BAR; PG8_MMA(1, 1, At, B1); PG8_BAR;
      PG8_LDB(B0, 1, 0); PG8_SCHED; PG8_LDA(At, 1, 0); PG8_STAGE(PG8_SA(0, 1), a2 + hstep, voffA);
      PG8_WAIT_L(8); PG8_BAR; PG8_WAIT_L(0); PG8_MMA(0, 0, At, B0); PG8_BAR; PG8_SCHED;
      PG8_LDB(B1, 1, 1); PG8_STAGE(PG8_SB(1, 0), b3, voffB);
      PG8_BAR; PG8_WAIT_L(0); PG8_MMA(0, 1, At, B1); PG8_BAR;
      PG8_LDA(At, 1, 1); PG8_STAGE(PG8_SA(1, 0), a3, voffA);
      PG8_BAR; PG8_WAIT_L(0); PG8_MMA(1, 0, At, B0); PG8_BAR; PG8_SCHED;
      PG8_STAGE(PG8_SB(1, 1), b3 + hstepB, voffB);
      PG8_WAIT_V(6); PG8_BAR; PG8_MMA(1, 1, At, B1); PG8_BAR;
    }
    E(acc, cur, wr, wc, fr, fq);
    if (!has_next) break;
#pragma unroll
    for (int a = 0; a < 2; ++a)
#pragma unroll
      for (int b = 0; b < 2; ++b)
#pragma unroll
        for (int m = 0; m < 4; ++m)
#pragma unroll
          for (int n = 0; n < 2; ++n) acc[a][b][m][n] = (f32x4){0.f, 0.f, 0.f, 0.f};
    cur = nxt; cA = nA; cB = nB; ++ui;
  }
  PG8_WAIT_V(0);
  if (wr == 0) PG8_BAR;
  PG8_BAR;
#undef PG8_SA
#undef PG8_SB
#undef PG8_STAGE
#undef PG8_LDA
#undef PG8_LDB
#undef PG8_MMA
#undef PG8_WAIT_V
#undef PG8_WAIT_L
#undef PG8_BAR
#undef PG8_SCHED
}
}

__device__ void merge_tile8(const Params& p, int layer, int tile, char* smem) {
  const int mt_ = tile % (TC / 256), nt_ = tile / (TC / 256);
  const int t512 = otid512(), lane = t512 & 63, w = t512 >> 6, wr = w >> 1, wc = w & 1;
  f32x4 acc[4][4], tot[4][4];
  zero_acc(tot);
#pragma unroll 1
  for (int br = 0; br < 3; ++br) {
    zero_acc(acc);
    const u16* A; const u16* Bt; int K;
    if (br == 0) { A = p.yssm + (size_t)mt_ * 256 * 1024; Bt = p.PsT + (size_t)layer * 1024 * 1024 + (size_t)nt_ * 128 * 1024; K = 1024; }
    else if (br == 1) { A = p.yattn + (size_t)mt_ * 256 * 512; Bt = p.PaT + (size_t)layer * 1024 * 512 + (size_t)nt_ * 128 * 512; K = 512; }
    else { A = p.ysc + (size_t)mt_ * 256 * 512; Bt = p.PcT + (size_t)layer * 1024 * 512 + (size_t)nt_ * 128 * 512; K = 512; }
    gemm_tile8(A, K, Bt, K, K, acc, smem);
#pragma unroll
    for (int mt = 0; mt < 4; ++mt) {
      const int m = mt_ * 256 + wr * 64 + mt * 16 + (lane & 15);
      const int n = nt_ * 128 + wc * 64 + (lane >> 4) * 16;
      const u16* gp = p.proj + paddr((size_t)m, CM + br * 1024 + n);
      float g16[16];
      unpack8(*(const U4*)gp, g16);
      unpack8(*(const U4*)(gp + 8), g16 + 8);
#pragma unroll
      for (int nt = 0; nt < 4; ++nt)
#pragma unroll
        for (int j = 0; j < 4; ++j) tot[mt][nt][j] += sigmoid_f(g16[nt * 4 + j]) * acc[mt][nt][j];
    }
  }
#pragma unroll
  for (int mt = 0; mt < 4; ++mt) {
    const int m = mt_ * 256 + wr * 64 + mt * 16 + (lane & 15);
    const int n = nt_ * 128 + wc * 64 + (lane >> 4) * 16;
    U4 o0, o1;
    o0.x = pack2(tot[mt][0][0], tot[mt][0][1]); o0.y = pack2(tot[mt][0][2], tot[mt][0][3]);
    o0.z = pack2(tot[mt][1][0], tot[mt][1][1]); o0.w = pack2(tot[mt][1][2], tot[mt][1][3]);
    o1.x = pack2(tot[mt][2][0], tot[mt][2][1]); o1.y = pack2(tot[mt][2][2], tot[mt][2][3]);
    o1.z = pack2(tot[mt][3][0], tot[mt][3][1]); o1.w = pack2(tot[mt][3][2], tot[mt][3][3]);
    u16* dp = p.Pa + (size_t)m * 1024 + n;
    *(U4*)dp = o0; *(U4*)(dp + 8) = o1;
  }
}

__device__ void wout_tile8(const Params& p, int layer, int tile, char* smem) {
  const int mt_ = tile % (TC / 256), nt_ = tile / (TC / 256);
  const int t512 = otid512(), lane = t512 & 63, w = t512 >> 6, wr = w >> 1, wc = w & 1;
  f32x4 acc[4][4];
  zero_acc(acc);
  gemm_tile8(p.Pa + (size_t)mt_ * 256 * 1024, 1024, p.WoT + (size_t)layer * 1024 * 1024 + (size_t)nt_ * 128 * 1024,
             1024, 1024, acc, smem);
#pragma unroll
  for (int mt = 0; mt < 4; ++mt) {
    const int m = mt_ * 256 + wr * 64 + mt * 16 + (lane & 15);
    const int n = nt_ * 128 + wc * 64 + (lane >> 4) * 16;
    U4 o0, o1;
    o0.x = pack2(acc[mt][0][0], acc[mt][0][1]); o0.y = pack2(acc[mt][0][2], acc[mt][0][3]);
    o0.z = pack2(acc[mt][1][0], acc[mt][1][1]); o0.w = pack2(acc[mt][1][2], acc[mt][1][3]);
    o1.x = pack2(acc[mt][2][0], acc[mt][2][1]); o1.y = pack2(acc[mt][2][2], acc[mt][2][3]);
    o1.z = pack2(acc[mt][3][0], acc[mt][3][1]); o1.w = pack2(acc[mt][3][2], acc[mt][3][3]);
    u16* dp = p.outA + (size_t)m * 1024 + n;
    *(U4*)dp = o0; *(U4*)(dp + 8) = o1;
  }
}

__device__ void resid_item(const Params& p, int layer, int ch, int it) {
  const int t512 = otid512();
  const int lane = t512 & 63, w = t512 >> 6;
  const int rl = it * 8 + w;
  const size_t rg = (size_t)ch * TC + rl;
  const float* xs = (layer == 0 ? p.x : p.out) + rg * D_;
  float* xd = p.out + rg * D_;
  const float* wp = p.norm_post + layer * D_;
  f32x4 o[4], xv[4], wv[4];
  float ps = 0.f;
#pragma unroll
  for (int i = 0; i < 4; ++i) {
    int c = (i * 64 + lane) * 4;
    U2 pa = *(const U2*)(p.outA + (size_t)rl * D_ + c);
    xv[i] = *(const f32x4*)(xs + c);
    wv[i] = *(const f32x4*)(wp + c);
    o[i].x = lo2f(pa.x); o[i].y = hi2f(pa.x); o[i].z = lo2f(pa.y); o[i].w = hi2f(pa.y);
    ps += o[i].x * o[i].x + o[i].y * o[i].y + o[i].z * o[i].z + o[i].w * o[i].w;
  }
  ps = wave_sum(ps);
  const float rstd = rsqrtf(ps * (1.f / D_) + EPS);
  f32x4 v[4];
  float ss = 0.f;
#pragma unroll
  for (int i = 0; i < 4; ++i) {
    int c = (i * 64 + lane) * 4;
    v[i] = xv[i] + o[i] * rstd * wv[i];
    *(f32x4*)(xd + c) = v[i];
    ss += v[i].x * v[i].x + v[i].y * v[i].y + v[i].z * v[i].z + v[i].w * v[i].w;
  }
  if (layer == 0) {
    ss = wave_sum(ss);
    float r2 = rsqrtf(ss * (1.f / D_) + EPS);
#pragma unroll
    for (int i = 0; i < 4; ++i) {
      U2 ov;
      ov.x = pack2(v[i].x * r2, v[i].y * r2);
      ov.y = pack2(v[i].z * r2, v[i].w * r2);
      *(U2*)(p.h + rg * D_ + (i * 64 + lane) * 4) = ov;
    }
  }
}

__device__ __forceinline__ void dt_cs_setup(const Params& p, int layer, size_t R0, int g, float* cs_s, float* dt_s,
                                            float& cs_last_out) {
  const int lane = otid() & 63, w = otid() >> 6;
  const int hd = g * 4 + w;
  const float bias = p.dt_bias[layer * 16 + hd];
  const float aneg = -__expf(p.a_log[layer * 16 + hd]);
  float d0 = softplus_f(bf2f(p.proj[paddr(R0 + lane, CDT + hd)]) + bias);
  float d1 = softplus_f(bf2f(p.proj[paddr(R0 + 64 + lane, CDT + hd)]) + bias);
  float c0 = d0 * aneg, c1 = d1 * aneg;
#pragma unroll
  for (int o = 1; o < 64; o <<= 1) {
    float t0 = __shfl_up(c0, o, 64), t1 = __shfl_up(c1, o, 64);
    if (lane >= o) { c0 += t0; c1 += t1; }
  }
  float tot0 = __shfl(c0, 63, 64);
  c1 += tot0;
  cs_last_out = __shfl(c1, 63, 64);
  cs_s[w * 128 + lane] = c0;
  cs_s[w * 128 + 64 + lane] = c1;
  dt_s[w * 128 + lane] = d0;
  dt_s[w * 128 + 64 + lane] = d1;
}

template <int NT>
__device__ __forceinline__ void conv_load(const u16* proj, size_t row0, int col, int tin0, U4 (&rows)[NT + 3]) {
#pragma unroll
  for (int i = 0; i < NT + 3; ++i) {
    const bool ok = (tin0 + i - 3) >= 0;
    U4 v = *(const U4*)(proj + paddr(ok ? row0 + i - 3 : row0, col));
    rows[i] = ok ? v : U4{0u, 0u, 0u, 0u};
  }
}
template <int NT, class F>
__device__ __forceinline__ void conv_compute(const U4 (&rows)[NT + 3], const float* cw, const float* cb, F&& emit) {
  f32x4 w0[4], w1[4];
#pragma unroll
  for (int k = 0; k < 4; ++k) { w0[k] = *(const f32x4*)(cw + k * 2048); w1[k] = *(const f32x4*)(cw + k * 2048 + 4); }
  const f32x4 b0 = *(const f32x4*)cb, b1 = *(const f32x4*)(cb + 4);
  float win[4][8];
  unpack8(rows[0], win[0]); unpack8(rows[1], win[1]); unpack8(rows[2], win[2]);
#pragma unroll
  for (int t = 0; t < NT; ++t) {
    unpack8(rows[t + 3], win[(t + 3) & 3]);
    float a8[8] = {b0.x, b0.y, b0.z, b0.w, b1.x, b1.y, b1.z, b1.w};
#pragma unroll
    for (int k = 0; k < 4; ++k) {
      const float* v8 = win[(t + k) & 3];
      a8[0] += w0[k].x * v8[0]; a8[1] += w0[k].y * v8[1]; a8[2] += w0[k].z * v8[2]; a8[3] += w0[k].w * v8[3];
      a8[4] += w1[k].x * v8[4]; a8[5] += w1[k].y * v8[5]; a8[6] += w1[k].z * v8[6]; a8[7] += w1[k].w * v8[7];
    }
#pragma unroll
    for (int e = 0; e < 8; ++e) a8[e] = silu_f(a8[e]);
    emit(t, a8);
  }
}

__device__ void ssd_passA(const Params& p, int layer, int it, char* smem) {
  const int tid = otid(), lane = tid & 63, w = __builtin_amdgcn_readfirstlane(tid >> 6);
  const int hp = it & 1, g = (it >> 1) & 3, c = (it >> 3) & 31, bl = it >> 8;
  const size_t R0 = (size_t)bl * S_ + c * 128;
  u16* Bt = (u16*)smem;
  u16* Xt = Bt + 128 * 136;
  float* cs_s = (float*)(smem + 69632);
  float* wg_s = cs_s + 256;
  const int hd0 = g * 4 + hp * 2;
  if (w < 2) {
    const int hd = hd0 + w;
    const float bias = p.dt_bias[layer * 16 + hd];
    const float aneg = -__expf(p.a_log[layer * 16 + hd]);
    float d0 = softplus_f(bf2f(p.proj[paddr(R0 + lane, CDT + hd)]) + bias);
    float d1 = softplus_f(bf2f(p.proj[paddr(R0 + 64 + lane, CDT + hd)]) + bias);
    float c0 = d0 * aneg, c1 = d1 * aneg;
#pragma unroll
    for (int o = 1; o < 64; o <<= 1) {
      float t0 = __shfl_up(c0, o, 64), t1 = __shfl_up(c1, o, 64);
      if (lane >= o) { c0 += t0; c1 += t1; }
    }
    c1 += __shfl(c0, 63, 64);
    const float cs_last = __shfl(c1, 63, 64);
    wg_s[w * 128 + lane] = d0 * __expf(cs_last - c0);
    wg_s[w * 128 + 64 + lane] = d1 * __expf(cs_last - c1);
    if (lane == 0) p.dec[((size_t)bl * 32 + c) * 16 + hd] = __expf(cs_last);
  }
  const float* cw = p.ssm_conv_w + (size_t)layer * 4 * 2048;
  const float* cb = p.ssm_conv_b + (size_t)layer * 2048;
  {
    const int chunk = tid & 31, tg = tid >> 5;
    const int chn = (chunk < 16) ? (hd0 * 64 + chunk * 8) : (1024 + g * 128 + (chunk - 16) * 8);
    u16* dst = (chunk < 16) ? (Xt + (chunk * 8) * 136) : (Bt + ((chunk - 16) * 8) * 136);
    const int t0 = tg * 16;
    const int chunkc = tid & 7, tgc = tid >> 3;
    const int chnc = 1536 + g * 128 + (hp * 8 + chunkc) * 8;
    const int t0c = tgc * 4;
    U4 rxb[19], rcc[7];
    conv_load<16>(p.proj, R0 + t0, CX + chn, c * 128 + t0, rxb);
    conv_load<4>(p.proj, R0 + t0c, CX + chnc, c * 128 + t0c, rcc);
    u16* xo = p.xc + (R0 + t0) * 2048 + chn;
    conv_compute<16>(rxb, cw + chn, cb + chn, [&](int t, const float* a8) {
      U4 ov = pack8(a8);
      *(U4*)(xo + (size_t)t * 2048) = ov;
      const int tok = t0 + t;
      u16* d = dst + ((((tok >> 3) ^ (chunk & 15)) << 3) | (tok & 7));
      d[0 * 136] = (u16)(ov.x & 0xffff); d[1 * 136] = (u16)(ov.x >> 16);
      d[2 * 136] = (u16)(ov.y & 0xffff); d[3 * 136] = (u16)(ov.y >> 16);
      d[4 * 136] = (u16)(ov.z & 0xffff); d[5 * 136] = (u16)(ov.z >> 16);
      d[6 * 136] = (u16)(ov.w & 0xffff); d[7 * 136] = (u16)(ov.w >> 16);
    });
    u16* xoc = p.xc + (R0 + t0c) * 2048 + chnc;
    conv_compute<4>(rcc, cw + chnc, cb + chnc, [&](int t, const float* a8) {
      *(U4*)(xoc + (size_t)t * 2048) = pack8(a8);
    });
  }
  __syncthreads();
#pragma unroll
  for (int i = 0; i < 8; ++i) {
    const int q = tid + 256 * i;
    const int row = q >> 4, part = q & 15;
    U4 v = *(const U4*)(Xt + row * 136 + ((part ^ ((row >> 3) & 15)) << 3));
    const size_t sx = ((size_t)bl * 32 + c) * 16 + hd0 + (row >> 6);
    *(U4*)(p.xT + sx * 8192 + (size_t)(row & 63) * 128 + part * 8) = v;
  }
  const int hl = w >> 1, nh = w & 1;
  const int r31 = lane & 31, hh = lane >> 5;
  f32x16 acc[2][2];
#pragma unroll
  for (int a = 0; a < 2; ++a)
#pragma unroll
    for (int b = 0; b < 2; ++b)
#pragma unroll
      for (int r = 0; r < 16; ++r) acc[a][b][r] = 0.f;
#pragma unroll 2
  for (int s = 0; s < 8; ++s) {
    float wv[8];
#pragma unroll
    for (int e = 0; e < 8; ++e) wv[e] = wg_s[hl * 128 + s * 16 + hh * 8 + e];
    bf16x8 xf[2];
#pragma unroll
    for (int pt = 0; pt < 2; ++pt) {
      const int xr = hl * 64 + pt * 32 + r31;
      U4 raw = *(const U4*)(Xt + xr * 136 + (((s * 2 + hh) ^ ((xr >> 3) & 15)) << 3));
      float v8[8];
      unpack8(raw, v8);
#pragma unroll
      for (int e = 0; e < 8; ++e) v8[e] *= wv[e];
      xf[pt] = as_bf16x8(pack8(v8));
    }
#pragma unroll
    for (int nt = 0; nt < 2; ++nt) {
      const int br = nh * 64 + nt * 32 + (((r31 >> 2) & 1) * 16 + (r31 & 3) + 4 * (r31 >> 3));
      bf16x8 bfr = ld_frag(Bt + br * 136 + (((s * 2 + hh) ^ ((br >> 3) & 15)) << 3));
#pragma unroll
      for (int pt = 0; pt < 2; ++pt) acc[nt][pt] = mfma32(bfr, xf[pt], acc[nt][pt]);
    }
  }
  {
    const size_t sidx = ((size_t)bl * 32 + c) * 16 + hd0 + hl;
#pragma unroll
    for (int nt = 0; nt < 2; ++nt)
#pragma unroll
      for (int pt = 0; pt < 2; ++pt)
#pragma unroll
        for (int h2 = 0; h2 < 2; ++h2) {
          U4 v;
          v.x = pack2(acc[nt][pt][h2 * 8 + 0], acc[nt][pt][h2 * 8 + 1]);
          v.y = pack2(acc[nt][pt][h2 * 8 + 2], acc[nt][pt][h2 * 8 + 3]);
          v.z = pack2(acc[nt][pt][h2 * 8 + 4], acc[nt][pt][h2 * 8 + 5]);
          v.w = pack2(acc[nt][pt][h2 * 8 + 6], acc[nt][pt][h2 * 8 + 7]);
          *(U4*)(p.stloc + sidx * 8192 + (size_t)(pt * 32 + r31) * 128 + nh * 64 + nt * 32 + hh * 16 + h2 * 8) = v;
        }
  }
  __syncthreads();
}

__device__ void ssd_scan_item(const Params& p, int it) {
  const int q = it * 512 + otid512();
  const int e2 = q & 4095, bh = q >> 12;
  const int bl = bh >> 4, hd = bh & 15;
  u32 lv[32];
  float dv[32];
#pragma unroll
  for (int c = 0; c < 32; ++c) {
    const size_t sidx = ((size_t)bl * 32 + c) * 16 + hd;
    lv[c] = *(const u32*)(p.stloc + sidx * 8192 + e2 * 2);
    dv[c] = p.dec[sidx];
  }
  float s0 = 0.f, s1 = 0.f;
#pragma unroll
  for (int c = 0; c < 32; ++c) {
    const size_t sidx = ((size_t)bl * 32 + c) * 16 + hd;
    *(u32*)(p.prev + sidx * 8192 + e2 * 2) = pack2(s0, s1);
    s0 = s0 * dv[c] + lo2f(lv[c]);
    s1 = s1 * dv[c] + hi2f(lv[c]);
  }
}

__device__ void ssd_passC(const Params& p, int layer, int it, char* smem) {
  const int tid = otid(), lane = tid & 63, w = __builtin_amdgcn_readfirstlane(tid >> 6);
  const int lh = it & 1, g = (it >> 1) & 3, c = (it >> 3) & 31, bl = it >> 8;
  const size_t R0 = (size_t)bl * S_ + c * 128;
  float* cs_s = (float*)smem;
  float* dt_s = cs_s + 512;
  float* ssq_s = (float*)(smem + 4096);
  const int strip = w >> 1, hp = w & 1;
  const int ntile = lh * 2 + strip + 1;
  const int r31 = lane & 31, hh = lane >> 5;
  const int l = (ntile - 1) * 32 + r31;
  bf16x8 cf[8];
  {
    const u16* cp = p.xc + (R0 + l) * 2048 + 1536 + g * 128 + hh * 8;
#pragma unroll
    for (int s = 0; s < 8; ++s) cf[s] = ld_frag(cp + s * 16);
  }
  {
    float dummy;
    dt_cs_setup(p, layer, R0, g, cs_s, dt_s, dummy);
  }
  __syncthreads();
  f32x16 gacc[4];
#pragma unroll
  for (int st = 0; st < 4; ++st) {
#pragma unroll
    for (int r = 0; r < 16; ++r) gacc[st][r] = 0.f;
    if (st < ntile) {
      const u16* bp = p.xc + (R0 + st * 32 + r31) * 2048 + 1024 + g * 128 + hh * 8;
#pragma unroll
      for (int s = 0; s < 8; ++s) gacc[st] = mfma32(ld_frag(bp + s * 16), cf[s], gacc[st]);
    }
  }
  U4* ypk = (U4*)(smem + 8192) + tid;
  float ssq = 0.f;
  const u16* xrow = p.xc + (R0 + l) * 2048;
  u16* yrow = p.yssm + (R0 + l) * 1024;
  const int pir = ((r31 >> 2) & 1) * 16 + (r31 & 3) + 4 * (r31 >> 3);
  const int loff = pir * 128 + hh * 8;
  const int xoff = pir * 128 + hh * 4;
#pragma unroll 1
  for (int j = 0; j < 2; ++j) {
    int hd = g * 4 + hp * 2 + j;
    asm volatile("" : "+s"(hd));
    const size_t sb = (((size_t)bl * 32 + c) * 16 + hd) * 8192;
    const u16* prevj = p.prev + sb;
    const u16* xTj = p.xT + sb;
    const float* csj = cs_s + (hd & 3) * 128;
    const float* dtj = dt_s + (hd & 3) * 128;
    f32x16 y[2];
#pragma unroll
    for (int pt = 0; pt < 2; ++pt) {
#pragma unroll
      for (int r = 0; r < 16; ++r) y[pt][r] = 0.f;
    }
#pragma unroll
    for (int s2 = 0; s2 < 4; ++s2) {
      bf16x8 f00 = ld_frag(prevj + loff + (2 * s2) * 16), f01 = ld_frag(prevj + loff + (2 * s2 + 1) * 16);
      bf16x8 f10 = ld_frag(prevj + loff + 32 * 128 + (2 * s2) * 16), f11 = ld_frag(prevj + loff + 32 * 128 + (2 * s2 + 1) * 16);
      y[0] = mfma32(f00, cf[2 * s2], y[0]);
      y[1] = mfma32(f10, cf[2 * s2], y[1]);
      y[0] = mfma32(f01, cf[2 * s2 + 1], y[0]);
      y[1] = mfma32(f11, cf[2 * s2 + 1], y[1]);
    }
    const float csl = csj[l];
    const float el = __expf(csl);
#pragma unroll
    for (int pt = 0; pt < 2; ++pt)
#pragma unroll
      for (int r = 0; r < 16; ++r) y[pt][r] *= el;
#pragma unroll
    for (int st = 0; st < 4; ++st) {
      if (st < ntile) {
#pragma unroll
        for (int ks = 0; ks < 2; ++ks) {
          float m8[8];
          {
            const int sb0 = 4 * hh + st * 32 + ks * 16;
            const f32x4 ca = *(const f32x4*)(csj + sb0), cb2 = *(const f32x4*)(csj + sb0 + 8);
            const f32x4 da = *(const f32x4*)(dtj + sb0), db2 = *(const f32x4*)(dtj + sb0 + 8);
#pragma unroll
            for (int jj = 0; jj < 4; ++jj) {
              m8[jj] = gacc[st][ks * 8 + jj] * __expf(csl - ca[jj]) * da[jj];
              m8[4 + jj] = gacc[st][ks * 8 + 4 + jj] * __expf(csl - cb2[jj]) * db2[jj];
            }
            if (st == ntile - 1) {
#pragma unroll
              for (int jj = 0; jj < 8; ++jj) {
                const int sloc = ks * 16 + 8 * (jj >> 2) + (jj & 3) + 4 * hh;
                m8[jj] = (sloc <= r31) ? m8[jj] : 0.f;
              }
            }
          }
          bf16x8 pf = as_bf16x8(pack8(m8));
#pragma unroll
          for (int pt = 0; pt < 2; ++pt) {
            const u16* xp = xTj + xoff + (pt * 32 * 128 + st * 32 + ks * 16);
            U2 x0 = *(const U2*)xp, x1 = *(const U2*)(xp + 8);
            U4 xv; xv.x = x0.x; xv.y = x0.y; xv.z = x1.x; xv.w = x1.y;
            y[pt] = mfma32(as_bf16x8(xv), pf, y[pt]);
          }
        }
      }
    }
    const float dsk = p.d_skip[layer * 16 + hd];
    const u16* xh = xrow + hd * 64 + hh * 16;
    const u16* zh = p.proj + paddr(R0 + l, CZ + hd * 64) + hh * 16;
    U4* ypj = ypk + (hd & 1) * 4 * 256;
#pragma unroll
    for (int pt = 0; pt < 2; ++pt) {
      float x16[16], z16[16], v16[16];
      unpack8(*(const U4*)(xh + pt * 32), x16); unpack8(*(const U4*)(xh + pt * 32 + 8), x16 + 8);
      unpack8(*(const U4*)(zh + pt * 32), z16); unpack8(*(const U4*)(zh + pt * 32 + 8), z16 + 8);
#pragma unroll
      for (int r = 0; r < 16; ++r) {
        v16[r] = (y[pt][r] + dsk * x16[r]) * silu_f(z16[r]);
        ssq += v16[r] * v16[r];
      }
      ypj[(pt * 2 + 0) * 256] = pack8(v16);
      ypj[(pt * 2 + 1) * 256] = pack8(v16 + 8);
    }
  }
  ssq += __shfl_xor(ssq, 32, 64);
  if (hh == 0) ssq_s[w * 32 + r31] = ssq;
  __syncthreads();
  ssq = ssq_s[w * 32 + r31] + ssq_s[(w ^ 1) * 32 + r31];
  const float rstd = rsqrtf(ssq * (1.f / 256.f) + EPS);
#pragma unroll 1
  for (int j = 0; j < 2; ++j) {
    int hd = g * 4 + hp * 2 + j;
    asm volatile("" : "+s"(hd));
    const float* nwp = p.ssm_norm + layer * 1024 + hd * 64 + hh * 16;
    u16* yh = yrow + hd * 64 + hh * 16;
    const U4* ypj = ypk + (hd & 1) * 4 * 256;
#pragma unroll
    for (int pt = 0; pt < 2; ++pt)
#pragma unroll
      for (int h2 = 0; h2 < 2; ++h2) {
        const f32x4 nw0 = *(const f32x4*)(nwp + pt * 32 + h2 * 8), nw1 = *(const f32x4*)(nwp + pt * 32 + h2 * 8 + 4);
        float v8[8];
        unpack8(ypj[(pt * 2 + h2) * 256], v8);
        v8[0] *= rstd * nw0.x; v8[1] *= rstd * nw0.y; v8[2] *= rstd * nw0.z; v8[3] *= rstd * nw0.w;
        v8[4] *= rstd * nw1.x; v8[5] *= rstd * nw1.y; v8[6] *= rstd * nw1.z; v8[7] *= rstd * nw1.w;
        *(U4*)(yh + pt * 32 + h2 * 8) = pack8(v8);
      }
  }
  __syncthreads();
}

__device__ __forceinline__ void attn_load(const Params& p, int it, int tid, U4 (&kreg)[8], U4 (&vreg)[8]) {
  const int blk = it & 31;
  int t2 = it >> 5;
  const int g = t2 % 3; t2 /= 3;
  const int kvh = t2 & 7, bl = t2 >> 3;
  const int dsh = 2 * g, d = 1 << dsh, nper = 32 >> dsh;
  const int r = blk / nper, n = blk % nper;
  const size_t Rb = (size_t)bl * S_;
#pragma unroll
  for (int i = 0; i < 8; ++i) {
    const int q = tid + 256 * i;
    const int row = q >> 3, chk = q & 7;
    const int ik = (n - 1) * 128 + row;
    const bool ok = ik >= 0;
    const size_t krow = Rb + (size_t)(ok ? ik : 0) * d + r;
    U4 kv = *(const U4*)(p.proj + paddr(krow, CK + kvh * 64 + chk * 8));
    U4 vv = *(const U4*)(p.proj + paddr(krow, CV + kvh * 64 + chk * 8));
    kreg[i] = ok ? kv : U4{0u, 0u, 0u, 0u};
    vreg[i] = ok ? vv : U4{0u, 0u, 0u, 0u};
  }
}

__device__ void attn_item(const Params& p, int it, int it_next, U4 (&kreg)[8], U4 (&vreg)[8], char* smem) {
  const int tid = otid(), lane = tid & 63, w = tid >> 6;
  const int blk = it & 31;
  int t2 = it >> 5;
  const int g = t2 % 3; t2 /= 3;
  const int kvh = t2 & 7, bl = t2 >> 3;
  const int dsh = 2 * g;
  const int d = 1 << dsh;
  const int nper = 32 >> dsh;
  const int r = blk / nper, n = blk % nper;
  u16* Ks = (u16*)smem;
  u16* Vs = Ks + 256 * 72;
  const size_t Rb = (size_t)bl * S_;
#pragma unroll
  for (int i = 0; i < 8; ++i) {
    int q = tid + 256 * i;
    int row = q >> 3, chk = q & 7;
    *(U4*)(Ks + row * 72 + chk * 8) = kreg[i];
    *(U4*)(Vs + row * 72 + chk * 8) = vreg[i];
  }
  const int r31 = lane & 31, hh = lane >> 5;
  const int iq = 32 * w + r31;
  const size_t rq_row = Rb + (size_t)(n * 128 + iq) * d + r;
  bf16x8 qf[4];
  {
    const u16* qp = p.proj + paddr(rq_row, CQ + g * 512 + kvh * 64) + hh * 8;
#pragma unroll
    for (int s = 0; s < 4; ++s) qf[s] = ld_frag(qp + s * 16);
  }
  __syncthreads();
  if (it_next >= 0) attn_load(p, it_next, tid, kreg, vreg);
  f32x16 sacc[5];
#pragma unroll
  for (int kt = 0; kt < 5; ++kt) {
#pragma unroll
    for (int rr = 0; rr < 16; ++rr) sacc[kt][rr] = 0.f;
    const u16* kp = Ks + (32 * (w + kt) + r31) * 72 + hh * 8;
#pragma unroll
    for (int s = 0; s < 4; ++s) sacc[kt] = mfma32(ld_frag(kp + s * 16), qf[s], sacc[kt]);
  }
  {
    const int tq = r31 - 4 * hh;
#pragma unroll
    for (int rr = 0; rr < 16; ++rr) {
      const int c = (rr & 3) + 8 * (rr >> 2);
      if (c < tq) sacc[0][rr] = -INFINITY;
      if (c > tq) sacc[4][rr] = -INFINITY;
    }
    if (n == 0) {
#pragma unroll
      for (int kt = 0; kt < 5; ++kt)
#pragma unroll
        for (int rr = 0; rr < 16; ++rr) {
          const int kk = 32 * (w + kt) + (rr & 3) + 8 * (rr >> 2) + 4 * hh;
          if (kk < 128) sacc[kt][rr] = -INFINITY;
        }
    }
  }
  float mx = -INFINITY;
#pragma unroll
  for (int kt = 0; kt < 5; ++kt)
#pragma unroll
    for (int rr = 0; rr < 16; ++rr) mx = fmaxf(mx, sacc[kt][rr]);
  mx = fmaxf(mx, __shfl_xor(mx, 32, 64));
  const float c2 = 0.125f * 1.4426950408889634f;
  const float mb = mx * c2;
  float den = 0.f;
#pragma unroll
  for (int kt = 0; kt < 5; ++kt)
#pragma unroll
    for (int rr = 0; rr < 16; ++rr) {
      float e = __builtin_amdgcn_exp2f(__builtin_fmaf(sacc[kt][rr], c2, -mb));
      sacc[kt][rr] = e;
      den += e;
    }
  den += __shfl_xor(den, 32, 64);
  f32x16 o[2];
#pragma unroll
  for (int et = 0; et < 2; ++et)
#pragma unroll
    for (int rr = 0; rr < 16; ++rr) o[et][rr] = 0.f;
#pragma unroll
  for (int kt = 0; kt < 5; ++kt)
#pragma unroll
    for (int ks = 0; ks < 2; ++ks) {
      float p8[8];
#pragma unroll
      for (int jj = 0; jj < 8; ++jj) p8[jj] = sacc[kt][ks * 8 + jj];
      bf16x8 pf = as_bf16x8(pack8(p8));
#pragma unroll
      for (int et = 0; et < 2; ++et) {
        const int trq = (lane & 15) >> 2, trp = lane & 3, trg = (lane >> 4) & 1;
        const u16* vp = Vs + (32 * (w + kt) + 16 * ks + 4 * hh + trq) * 72 + et * 32 + 16 * (trp & 1) + 8 * trg + 4 * (trp >> 1);
        typedef short v4s_t __attribute__((ext_vector_type(4)));
        v4s_t v0 = __builtin_amdgcn_ds_read_tr16_b64_v4i16((LAS v4s_t*)vp);
        v4s_t v1 = __builtin_amdgcn_ds_read_tr16_b64_v4i16((LAS v4s_t*)(vp + 8 * 72));
        bf16x8 vfr;
        vfr[0] = v0[0]; vfr[1] = v0[1]; vfr[2] = v0[2]; vfr[3] = v0[3];
        vfr[4] = v1[0]; vfr[5] = v1[1]; vfr[6] = v1[2]; vfr[7] = v1[3];
        o[et] = mfma32(vfr, pf, o[et]);
      }
    }
  const float inv = __builtin_amdgcn_rcpf(den);
  const size_t rloc = rq_row;
  u16* op = p.og + ((size_t)g * TC + rloc) * 512 + kvh * 64;
#pragma unroll
  for (int et = 0; et < 2; ++et)
#pragma unroll
    for (int h2 = 0; h2 < 2; ++h2) {
      U4 ov;
      ov.x = pack2(o[et][h2 * 8 + 0] * inv, o[et][h2 * 8 + 1] * inv);
      ov.y = pack2(o[et][h2 * 8 + 2] * inv, o[et][h2 * 8 + 3] * inv);
      ov.z = pack2(o[et][h2 * 8 + 4] * inv, o[et][h2 * 8 + 5] * inv);
      ov.w = pack2(o[et][h2 * 8 + 6] * inv, o[et][h2 * 8 + 7] * inv);
      *(U4*)(op + et * 32 + hh * 16 + h2 * 8) = ov;
    }
  if (hh == 0) p.lse[((size_t)g * TC + rloc) * 8 + kvh] = mx * 0.125f + __logf(den);
  __syncthreads();
}

__device__ void attn_combine_item(const Params& p, int it) {
  const int t512 = otid512();
  const int chk = t512 & 63, kvh = chk >> 3;
  float l0[4], l1[4], l2[4];
  U4 ra[4], rb[4], rc[4], rg[4];
#pragma unroll
  for (int i = 0; i < 4; ++i) {
    const size_t row = (size_t)((it * 4 + i) * 512 + t512) >> 6;
    l0[i] = p.lse[((size_t)0 * TC + row) * 8 + kvh];
    l1[i] = p.lse[((size_t)1 * TC + row) * 8 + kvh];
    l2[i] = p.lse[((size_t)2 * TC + row) * 8 + kvh];
    ra[i] = *(const U4*)(p.og + ((size_t)0 * TC + row) * 512 + chk * 8);
    rb[i] = *(const U4*)(p.og + ((size_t)1 * TC + row) * 512 + chk * 8);
    rc[i] = *(const U4*)(p.og + ((size_t)2 * TC + row) * 512 + chk * 8);
    rg[i] = *(const U4*)(p.proj + paddr(row, CGA + chk * 8));
  }
#pragma unroll
  for (int i = 0; i < 4; ++i) {
    const size_t row = (size_t)((it * 4 + i) * 512 + t512) >> 6;
    float m = fmaxf(l0[i], fmaxf(l1[i], l2[i]));
    float e0 = __expf(l0[i] - m), e1 = __expf(l1[i] - m), e2 = __expf(l2[i] - m);
    float inv = __builtin_amdgcn_rcpf(e0 + e1 + e2);
    e0 *= inv; e1 *= inv; e2 *= inv;
    float a[8], b[8], c[8], gt[8], o[8];
    unpack8(ra[i], a); unpack8(rb[i], b); unpack8(rc[i], c); unpack8(rg[i], gt);
#pragma unroll
    for (int e = 0; e < 8; ++e) o[e] = (e0 * a[e] + e1 * b[e] + e2 * c[e]) * silu_f(gt[e]);
    *(U4*)(p.yattn + row * 512 + chk * 8) = pack8(o);
  }
}

__device__ void shortconv_item(const Params& p, int layer, int it) {
  const float* cw = p.sc_conv_w + (size_t)layer * 3 * 512;
  const int t512 = otid512();
  const int chk = t512 & 63;
  f32x4 w0[3], w1[3];
#pragma unroll
  for (int k = 0; k < 3; ++k) { w0[k] = *(const f32x4*)(cw + k * 512 + chk * 8); w1[k] = *(const f32x4*)(cw + k * 512 + chk * 8 + 4); }
#pragma unroll
  for (int ip = 0; ip < 2; ++ip) {
    U4 ru[2][3], rc[2][3], rb[2], rgs[2];
#pragma unroll
    for (int j = 0; j < 2; ++j) {
      const size_t row = (size_t)((it * 4 + ip * 2 + j) * 512 + t512) >> 6;
      const int tin = (int)(row & (S_ - 1));
#pragma unroll
      for (int k = 0; k < 3; ++k) {
        const bool ok = tin - 2 + k >= 0;
        const size_t rr = ok ? row - 2 + k : row;
        U4 u = *(const U4*)(p.proj + paddr(rr, CU + chk * 8));
        U4 c = *(const U4*)(p.proj + paddr(rr, CCS + chk * 8));
        ru[j][k] = ok ? u : U4{0u, 0u, 0u, 0u};
        rc[j][k] = ok ? c : U4{0u, 0u, 0u, 0u};
      }
      rb[j] = *(const U4*)(p.proj + paddr(row, CBS + chk * 8));
      rgs[j] = *(const U4*)(p.proj + paddr(row, CGS + chk * 8));
    }
#pragma unroll
    for (int j = 0; j < 2; ++j) {
      const size_t row = (size_t)((it * 4 + ip * 2 + j) * 512 + t512) >> 6;
      float acc[8];
#pragma unroll
      for (int e = 0; e < 8; ++e) acc[e] = 0.f;
#pragma unroll
      for (int k = 0; k < 3; ++k) {
        float u8[8], c8[8];
        unpack8(ru[j][k], u8); unpack8(rc[j][k], c8);
        acc[0] += w0[k].x * (c8[0] * u8[0]); acc[1] += w0[k].y * (c8[1] * u8[1]);
        acc[2] += w0[k].z * (c8[2] * u8[2]); acc[3] += w0[k].w * (c8[3] * u8[3]);
        acc[4] += w1[k].x * (c8[4] * u8[4]); acc[5] += w1[k].y * (c8[5] * u8[5]);
        acc[6] += w1[k].z * (c8[6] * u8[6]); acc[7] += w1[k].w * (c8[7] * u8[7]);
      }
      float b8[8], g8[8], o[8];
      unpack8(rb[j], b8); unpack8(rgs[j], g8);
#pragma unroll
      for (int e = 0; e < 8; ++e) o[e] = b8[e] * acc[e] * silu_f(g8[e]);
      *(U4*)(p.ysc + row * 512 + chk * 8) = pack8(o);
    }
  }
}

struct ScanSt { u32 lv[32]; float dv[32]; };
struct CombSt { float l0[4], l1[4], l2[4]; U4 ra[4], rb[4], rc[4], rg[4]; };
struct ResSt { f32x4 o[4], xv[4], wv[4]; };
__device__ __forceinline__ void scan_load(const Params& p, int it, int t512, ScanSt& st) {
  const int q = it * 512 + t512;
  const int e2 = q & 4095, bh = q >> 12, bl = bh >> 4, hd = bh & 15;
#pragma unroll
  for (int c = 0; c < 32; ++c) {
    const size_t sidx = ((size_t)bl * 32 + c) * 16 + hd;
    st.lv[c] = *(const u32*)(p.stloc + sidx * 8192 + e2 * 2);
    st.dv[c] = p.dec[sidx];
  }
}
__device__ __forceinline__ void scan_fin(const Params& p, int it, int t512, const ScanSt& st) {
  const int q = it * 512 + t512;
  const int e2 = q & 4095, bh = q >> 12, bl = bh >> 4, hd = bh & 15;
  float s0 = 0.f, s1 = 0.f;
#pragma unroll
  for (int c = 0; c < 32; ++c) {
    const size_t sidx = ((size_t)bl * 32 + c) * 16 + hd;
    *(u32*)(p.prev + sidx * 8192 + e2 * 2) = pack2(s0, s1);
    s0 = s0 * st.dv[c] + lo2f(st.lv[c]);
    s1 = s1 * st.dv[c] + hi2f(st.lv[c]);
  }
}
__device__ __forceinline__ void comb_load(const Params& p, int it, int t512, CombSt& st) {
  const int chk = t512 & 63, kvh = chk >> 3;
#pragma unroll
  for (int i = 0; i < 4; ++i) {
    const size_t row = (size_t)((it * 4 + i) * 512 + t512) >> 6;
    st.l0[i] = p.lse[((size_t)0 * TC + row) * 8 + kvh];
    st.l1[i] = p.lse[((size_t)1 * TC + row) * 8 + kvh];
    st.l2[i] = p.lse[((size_t)2 * TC + row) * 8 + kvh];
    st.ra[i] = *(const U4*)(p.og + ((size_t)0 * TC + row) * 512 + chk * 8);
    st.rb[i] = *(const U4*)(p.og + ((size_t)1 * TC + row) * 512 + chk * 8);
    st.rc[i] = *(const U4*)(p.og + ((size_t)2 * TC + row) * 512 + chk * 8);
    st.rg[i] = *(const U4*)(p.proj + paddr(row, CGA + chk * 8));
  }
}
__device__ __forceinline__ void comb_fin(const Params& p, int it, int t512, const CombSt& st) {
  const int chk = t512 & 63;
#pragma unroll
  for (int i = 0; i < 4; ++i) {
    const size_t row = (size_t)((it * 4 + i) * 512 + t512) >> 6;
    float m = fmaxf(st.l0[i], fmaxf(st.l1[i], st.l2[i]));
    float e0 = __expf(st.l0[i] - m), e1 = __expf(st.l1[i] - m), e2 = __expf(st.l2[i] - m);
    float inv = __builtin_amdgcn_rcpf(e0 + e1 + e2);
    e0 *= inv; e1 *= inv; e2 *= inv;
    float a[8], b[8], c[8], gt[8], o[8];
    unpack8(st.ra[i], a); unpack8(st.rb[i], b); unpack8(st.rc[i], c); unpack8(st.rg[i], gt);
#pragma unroll
    for (int e = 0; e < 8; ++e) o[e] = (e0 * a[e] + e1 * b[e] + e2 * c[e]) * silu_f(gt[e]);
    *(U4*)(p.yattn + row * 512 + chk * 8) = pack8(o);
  }
}
__device__ __forceinline__ void res_load(const Params& p, int layer, int ch, int it, int t512, ResSt& st) {
  const int lane = t512 & 63, w = t512 >> 6;
  const int rl = it * 8 + w;
  const size_t rg = (size_t)ch * TC + rl;
  const float* xs = (layer == 0 ? p.x : p.out) + rg * D_;
  const float* wp = p.norm_post + layer * D_;
#pragma unroll
  for (int i = 0; i < 4; ++i) {
    int c = (i * 64 + lane) * 4;
    U2 pa = *(const U2*)(p.outA + (size_t)rl * D_ + c);
    st.xv[i] = *(const f32x4*)(xs + c);
    st.wv[i] = *(const f32x4*)(wp + c);
    st.o[i].x = lo2f(pa.x); st.o[i].y = hi2f(pa.x); st.o[i].z = lo2f(pa.y); st.o[i].w = hi2f(pa.y);
  }
}
__device__ __forceinline__ void res_fin(const Params& p, int layer, int ch, int it, int t512, const ResSt& st) {
  const int lane = t512 & 63, w = t512 >> 6;
  const int rl = it * 8 + w;
  const size_t rg = (size_t)ch * TC + rl;
  float* xd = p.out + rg * D_;
  float ps = 0.f;
#pragma unroll
  for (int i = 0; i < 4; ++i) ps += st.o[i].x * st.o[i].x + st.o[i].y * st.o[i].y + st.o[i].z * st.o[i].z + st.o[i].w * st.o[i].w;
  ps = wave_sum(ps);
  const float rstd = rsqrtf(ps * (1.f / D_) + EPS);
  f32x4 v[4];
  float ss = 0.f;
#pragma unroll
  for (int i = 0; i < 4; ++i) {
    int c = (i * 64 + lane) * 4;
    v[i] = st.xv[i] + st.o[i] * rstd * st.wv[i];
    *(f32x4*)(xd + c) = v[i];
    ss += v[i].x * v[i].x + v[i].y * v[i].y + v[i].z * v[i].z + v[i].w * v[i].w;
  }
  if (layer == 0) {
    ss = wave_sum(ss);
    float r2 = rsqrtf(ss * (1.f / D_) + EPS);
#pragma unroll
    for (int i = 0; i < 4; ++i) {
      U2 ov;
      ov.x = pack2(v[i].x * r2, v[i].y * r2);
      ov.y = pack2(v[i].z * r2, v[i].w * r2);
      *(U2*)(p.h + rg * D_ + (i * 64 + lane) * 4) = ov;
    }
  }
}

__device__ __forceinline__ void do_phase(const Params& p, int ph, int layer, int ch, char* smem0, int dup = 0) {
  const int G = gridDim.x, b0 = blockIdx.x;
  const int half_ = __builtin_amdgcn_readfirstlane(otid512() >> 8);
  char* smem = smem0 + half_ * HSMEM;
  if (ph == 0) {
    phase_weights(p, smem0);
  } else if (ph == 1) {
    pg8::Sched S; pg8::Epi E;
    E.O16 = p.proj; E.ld16 = NP; E.T16 = p.proj; E.ldt = NP; E.gate = p.proj; E.ldg = NP;
    S.kind = 0; S.so.init(TC, NP, G, b0); S.n = 0; S.mode0 = 0;
    S.gA = (const char*)(p.h + (size_t)ch * TC * D_); S.gB = (const char*)(p.WinT + (size_t)layer * NP * D_);
    S.tstep = (size_t)256 * D_ * 2;
    S.u0.pm = 0; S.u0.pn = 0; S.u0.a = S.gA; S.u0.b = S.gB; S.u0.mode = 0; S.u0.gcol = 0; S.u1 = S.u0;
    __syncthreads();
    pg8::gemm_phase((LAS unsigned char*)smem0, D_, S, E);
    {
      const int idx = layer * NCH + ch;
      constexpr int NWG = (TC / 256) * (NP / 256);
      const int nlong = NWG % G;
      if (idx > 0 && b0 >= nlong) {
        const int pl = (idx - 1) / NCH, pc = (idx - 1) % NCH;
        for (int it = b0 - nlong; it < NR1; it += G - nlong) resid_item(p, pl, pc, it);
      }
    }
  } else if (ph == 2) {
    constexpr int NA = NB * 32 * 4 * 2 / 2, NATT = NB * 8 * 3 * 32 / 2, NSC = TC * 64 / 2048;
    for (int sl = b0; sl < NA; sl += G) ssd_passA(p, layer, 2 * sl + half_, smem);
    {
      U4 kreg[8], vreg[8];
      int sl = (b0 + G - (NA % G)) % G;
      if (sl < NATT) attn_load(p, 2 * sl + half_, otid(), kreg, vreg);
      for (; sl < NATT; sl += G) {
        const int nx = sl + G;
        attn_item(p, 2 * sl + half_, nx < NATT ? 2 * nx + half_ : -1, kreg, vreg, smem);
      }
    }
    for (int it = (b0 + G - ((NA + NATT) % G)) % G; it < NSC; it += G) shortconv_item(p, layer, it);
  } else if (ph == 3) {
    constexpr int NS = NB * 16 * 4096 / 512, NCMB = TC * 64 / 2048;
    const int idx = layer * NCH + ch;
    const int pl = idx > 0 ? (idx - 1) / NCH : 0, pc = idx > 0 ? (idx - 1) % NCH : 0;
    const int t512 = otid512();
    for (int k = b0; k < NS || k < NCMB || (idx > 0 && NR1 + k < TC / 8); k += G) {
      const bool hs = k < NS, hc = k < NCMB, hr = idx > 0 && (NR1 + k) < TC / 8;
      ScanSt ss; CombSt cs; ResSt rs;
      if (hs) scan_load(p, k, t512, ss);
      if (hc) comb_load(p, k, t512, cs);
      if (hr) res_load(p, pl, pc, NR1 + k, t512, rs);
      if (hs) scan_fin(p, k, t512, ss);
      if (hc) comb_fin(p, k, t512, cs);
      if (hr) res_fin(p, pl, pc, NR1 + k, t512, rs);
    }
  } else if (ph == 4) {
    for (int sl = b0; sl < NB * 32 * 4 * 2 / 2; sl += G) ssd_passC(p, layer, 2 * sl + half_, smem);
  } else if (ph == 5) {
    for (int it = b0; it < (TC / 256) * 8; it += G) merge_tile8(p, layer, it, smem0);
  } else if (ph == 6) {
    for (int it = b0; it < (TC / 256) * 8; it += G) wout_tile8(p, layer, it, smem0);
  } else {
    for (int it = b0; it < TC / 8; it += G) resid_item(p, 1, NCH - 1, it);
  }
}

#define XB_TMO      128
#define XB_XCNT(j)  (256  + 64 * (j))
#define XB_XSUB(j)  (1280 + 64 * (j))
#define XB_XGEN(j)  (2304 + 64 * (j))
#define XB_TOP      3328
#define XB_TOPGEN   3392
#define XCD_BAR_WORDS 3456
#define XB_SPIN_CAP (1u << 20)
__device__ __forceinline__ unsigned xb_ld(unsigned* p) { return __hip_atomic_load(p, __ATOMIC_RELAXED, __HIP_MEMORY_SCOPE_AGENT); }
__device__ __forceinline__ unsigned xb_add(unsigned* p, unsigned v) { return __hip_atomic_fetch_add(p, v, __ATOMIC_RELAXED, __HIP_MEMORY_SCOPE_AGENT); }
__device__ __forceinline__ unsigned xb_xcc_id() { return (unsigned)__builtin_amdgcn_s_getreg((3 << 11) | 20) & 0xFu; }
#define XB_SPIN(cond, bar) do { unsigned _sp = 0; while (cond) { __builtin_amdgcn_s_sleep(1); \
    if ((++_sp & 255u) == 0u) { if (xb_ld(&(bar)[XB_TMO])) break; if (_sp > XB_SPIN_CAP) { atomicAdd(&(bar)[XB_TMO], 1u); break; } } } } while (0)
struct XcdBarrier { unsigned* bar; unsigned x; volatile LAS unsigned* st; };
__device__ __forceinline__ XcdBarrier xcd_barrier_post(unsigned* bar, volatile LAS unsigned* st) {
  XcdBarrier b; b.bar = bar; b.x = xb_xcc_id(); b.st = st;
  if (threadIdx.x == 0) (void)xb_add(&bar[XB_XCNT(b.x)], 1u);
  return b;
}
__device__ __forceinline__ void xcd_barrier_complete(unsigned* bar, unsigned x, unsigned& nloc, unsigned& nx) {
  const unsigned G = gridDim.x * gridDim.y * gridDim.z;
  unsigned sum, cnt, mine, sp = 0u;
  for (;;) {
    sum = 0u; cnt = 0u; mine = 0u;
#pragma unroll
    for (unsigned j = 0; j < 16; ++j) { const unsigned c = xb_ld(&bar[XB_XCNT(j)]); sum += c; cnt += (c > 0u) ? 1u : 0u; mine = (j == x) ? c : mine; }
    if (sum == G) break;
    __builtin_amdgcn_s_sleep(1);
    if ((++sp & 255u) == 0u) { if (xb_ld(&bar[XB_TMO])) break; if (sp > XB_SPIN_CAP) { atomicAdd(&bar[XB_TMO], 1u); break; } }
  }
  nloc = mine > 0u ? mine : 1u; nx = cnt > 0u ? cnt : 1u;
}
__device__ __forceinline__ void xcd_barrier(const XcdBarrier& b) {
  asm volatile("s_waitcnt vmcnt(0)" ::: "memory");
  __syncthreads();
  if (threadIdx.x == 0) {
    unsigned* bar = b.bar;
    __builtin_amdgcn_s_waitcnt(0);
    unsigned nloc = b.st[0], nx = b.st[1];
    if (nloc == 0u) { xcd_barrier_complete(bar, b.x, nloc, nx); b.st[0] = nloc; b.st[1] = nx; }
    const unsigned old = xb_add(&bar[XB_XSUB(b.x)], 1u);
    const unsigned gen = old / nloc;
    if (old + 1u == (gen + 1u) * nloc) {
      __builtin_amdgcn_fence(__ATOMIC_RELEASE, "agent");
      asm volatile("s_waitcnt vmcnt(0)" ::: "memory");
      const unsigned og = xb_add(&bar[XB_TOP], 1u);
      const unsigned tg = og / nx;
      if (og + 1u == (tg + 1u) * nx) xb_add(&bar[XB_TOPGEN], 1u);
      else XB_SPIN(xb_ld(&bar[XB_TOPGEN]) == tg, bar);
      __builtin_amdgcn_fence(__ATOMIC_ACQUIRE, "agent");
      xb_add(&bar[XB_XGEN(b.x)], 1u);
      asm volatile("s_waitcnt vmcnt(0)" ::: "memory");
    } else {
      XB_SPIN(xb_ld(&bar[XB_XGEN(b.x)]) == gen, bar);
      __builtin_amdgcn_fence(__ATOMIC_ACQUIRE, "agent");
      asm volatile("s_waitcnt vmcnt(0)" ::: "memory");
    }
  }
  __syncthreads();
}

#if COOP
__global__ void __launch_bounds__(512, 2) mega_kernel(Params p) {
  extern __shared__ __attribute__((aligned(16))) char smem[];
  cg::grid_group grid = cg::this_grid();
#ifdef ONLY_PH
  do_phase(p, ONLY_PH, 0, 1, smem); return;
#endif
  constexpr int NSTEP = 2 + 2 * NCH * 6;
  volatile LAS unsigned* st = (volatile LAS unsigned*)(LAS unsigned char*)(smem + SMEM_BYTES);
  if (threadIdx.x < 4) st[threadIdx.x] = 0u;
  if (blockIdx.x == 0) for (int i = threadIdx.x; i < XCD_BAR_WORDS; i += 512) p.bar[i] = 0u;
  __syncthreads();
  XcdBarrier xb;
#pragma unroll 1
  for (int step = 0; step < NSTEP; ++step) {
    int ph, layer, ch;
    if (step == 0) { ph = 0; layer = 0; ch = 0; }
    else if (step == NSTEP - 1) { ph = 7; layer = 1; ch = NCH - 1; }
    else {
      int s1 = step - 1;
      ph = 1 + s1 % 6;
      int it = s1 / 6;
      layer = it / NCH; ch = it % NCH;
    }
    do_phase(p, ph, layer, ch, smem);
#ifdef DUP_PH
    if (ph == DUP_PH) { xcd_barrier(xb); do_phase(p, ph, layer, ch, smem, 1); }
#endif
    if (step == 0) {
      grid.sync();
      xb = xcd_barrier_post(p.bar, st);
    } else if (step != NSTEP - 1) {
      xcd_barrier(xb);
    }
  }
}
#else
__global__ void __launch_bounds__(512, 2) phase_kernel(Params p, int ph, int layer, int ch) {
  extern __shared__ __attribute__((aligned(16))) char smem[];
  do_phase(p, ph, layer, ch, smem);
}
#endif

extern "C" void kernel_launch(void* const* d_in, const int* in_sizes, int n_in, void* d_out, int out_size, void* d_ws,
                              size_t ws_size, hipStream_t stream) {
  Params p{};
  p.x = (const float*)d_in[0]; p.norm_pre = (const float*)d_in[1]; p.norm_post = (const float*)d_in[2];
  p.w_in = (const float*)d_in[3]; p.ssm_conv_w = (const float*)d_in[4]; p.ssm_conv_b = (const float*)d_in[5];
  p.dt_bias = (const float*)d_in[6]; p.a_log = (const float*)d_in[7]; p.d_skip = (const float*)d_in[8];
  p.ssm_norm = (const float*)d_in[9]; p.sc_conv_w = (const float*)d_in[10]; p.p_ssm = (const float*)d_in[11];
  p.p_attn = (const float*)d_in[12]; p.p_sc = (const float*)d_in[13]; p.w_out = (const float*)d_in[14];
  p.out = (float*)d_out;
  char* ws = (char*)d_ws;
  size_t off = 0;
  auto take = [&](size_t bytes) { char* r = ws + off; off += (bytes + 255) & ~(size_t)255; return r; };
  p.WinT = (u16*)take((size_t)2 * NP * D_ * 2);
  p.PsT = (u16*)take((size_t)2 * 1024 * 1024 * 2);
  p.PaT = (u16*)take((size_t)2 * 1024 * 512 * 2);
  p.PcT = (u16*)take((size_t)2 * 1024 * 512 * 2);
  p.WoT = (u16*)take((size_t)2 * 1024 * 1024 * 2);
  p.h = (u16*)take((size_t)T_ * D_ * 2);
  p.proj = (u16*)take((size_t)TC * NP * 2);
  p.xc = (u16*)take((size_t)TC * 2048 * 2);
  p.xT = (u16*)take((size_t)NB * 32 * 16 * 8192 * 2);
  p.prev = (u16*)take((size_t)NB * 32 * 16 * 8192 * 2);
  p.og = (u16*)take((size_t)3 * TC * 512 * 2);
  p.yattn = (u16*)take((size_t)TC * 512 * 2);
  p.ysc = (u16*)take((size_t)TC * 512 * 2);
  p.yssm = (u16*)take((size_t)TC * 1024 * 2);
  p.Pa = (u16*)take((size_t)TC * 1024 * 2);
  p.Pb = p.og;
  p.stloc = (u16*)take((size_t)NB * 32 * 16 * 8192 * 2);
  p.outA = (u16*)take((size_t)TC * 1024 * 2);
  p.outB = p.xc;
  p.dec = (float*)take((size_t)NB * 32 * 16 * 4);
  p.lse = (float*)take((size_t)3 * TC * 8 * 4);
  p.bar = (unsigned*)take((size_t)XCD_BAR_WORDS * 4);
  if (off > ws_size) fprintf(stderr, "workspace too small: need %zu have %zu\n", off, ws_size);
#if COOP
  static int grid_blocks = 0;
  if (!grid_blocks) {
    int dev = 0, cus = 0, per_cu = 0;
    hipGetDevice(&dev);
    hipDeviceGetAttribute(&cus, hipDeviceAttributeMultiprocessorCount, dev);
    hipFuncSetAttribute((const void*)mega_kernel, hipFuncAttributeMaxDynamicSharedMemorySize, SMEM_BYTES + 16);
    hipOccupancyMaxActiveBlocksPerMultiprocessor(&per_cu, mega_kernel, 512, SMEM_BYTES + 16);
    if (per_cu > 1) per_cu = 1;
    grid_blocks = cus * per_cu;
  }
  void* args[] = {&p};
  hipError_t e = hipLaunchCooperativeKernel((void*)mega_kernel, dim3(grid_blocks), dim3(512), args, SMEM_BYTES + 16, stream);
  if (e != hipSuccess) fprintf(stderr, "cooperative launch failed: %s (grid %d)\n", hipGetErrorString(e), grid_blocks);
#else
  const int grid = 256;
  hipFuncSetAttribute((const void*)phase_kernel, hipFuncAttributeMaxDynamicSharedMemorySize, SMEM_BYTES);
  phase_kernel<<<grid, 512, SMEM_BYTES, stream>>>(p, 0, 0, 0);
  for (int layer = 0; layer < 2; ++layer)
    for (int ch = 0; ch < NCH; ++ch)
      for (int ph = 1; ph <= 6; ++ph) phase_kernel<<<grid, 512, SMEM_BYTES, stream>>>(p, ph, layer, ch);
  phase_kernel<<<grid, 512, SMEM_BYTES, stream>>>(p, 7, 1, NCH - 1);
#endif
}
```

```cpp
#include <hip/hip_runtime.h>
#include <hip/hip_cooperative_groups.h>
#include <cstdio>
#include <cstdint>
namespace cg = cooperative_groups;

#ifndef COOP
#define COOP 1
#endif

typedef unsigned short u16;
typedef unsigned int u32;
using bf16x8 = __attribute__((ext_vector_type(8))) short;
using f32x4 = __attribute__((ext_vector_type(4))) float;
using f32x16 = __attribute__((ext_vector_type(16))) float;
using U4 = __attribute__((ext_vector_type(4))) unsigned int;
using U2 = __attribute__((ext_vector_type(2))) unsigned int;

constexpr int D_ = 1024, S_ = 4096, NBATCH = 8, T_ = NBATCH * S_;
constexpr int NB = 2, TC = NB * S_, NCH = NBATCH / NB;
constexpr int NP = 11520;
constexpr int NORIG = 11280;
constexpr int CZ = 0, CX = 1024, CQ = 3072, CK = 4608, CV = 5120, CGA = 5632, CU = 6144, CBS = 6656,
              CCS = 7168, CGS = 7680, CM = 8192, CDT = 11264;
constexpr int NR1 = 768;
constexpr int HSMEM = 73728;
constexpr int SMEM_BYTES = 2 * HSMEM;
constexpr float EPS = 1e-6f;
__host__ __device__ __forceinline__ size_t paddr(size_t row, int col) {
  return ((((row >> 8) * (size_t)(NP / 256) + (size_t)(col >> 8)) * 16 + ((row >> 4) & 15)) * 4 + (size_t)((col >> 6) & 3)) * 1024 +
         (row & 15) * 64 + (size_t)(col & 63);
}

struct Params {
  const float *x, *norm_pre, *norm_post, *w_in, *ssm_conv_w, *ssm_conv_b, *dt_bias, *a_log, *d_skip,
      *ssm_norm, *sc_conv_w, *p_ssm, *p_attn, *p_sc, *w_out;
  float* out;
  u16 *WinT, *PsT, *PaT, *PcT, *WoT;
  u16 *h, *proj, *xc, *xT, *prev, *og, *yattn, *ysc, *yssm, *Pa, *Pb;
  float *dec, *lse;
  u16 *stloc, *outA, *outB;
  unsigned* bar;
};

__device__ __forceinline__ u32 pack2(float a, float b);
__device__ __forceinline__ int otid512() { int t = threadIdx.x; asm volatile("" : "+v"(t)); return t; }
__device__ __forceinline__ int otid() { return otid512() & 255; }
__device__ __forceinline__ u32 cvt_pk_bf16(float lo, float hi) { return pack2(lo, hi); }
__device__ __forceinline__ u16 f2bf(float f) {
  u32 u = __float_as_uint(f);
  u += 0x7fffu + ((u >> 16) & 1u);
  return (u16)(u >> 16);
}
__device__ __forceinline__ float bf2f(u16 h) { return __uint_as_float(((u32)h) << 16); }
__device__ __forceinline__ u32 pack2(float a, float b);
typedef float f32x2_t __attribute__((ext_vector_type(2)));
typedef __bf16 bf16x2_t __attribute__((ext_vector_type(2)));
__device__ __forceinline__ u32 pack2(float a, float b) { f32x2_t v = {a, b}; return __builtin_bit_cast(u32, __builtin_convertvector(v, bf16x2_t)); }
__device__ __forceinline__ float lo2f(u32 v) { return __uint_as_float(v << 16); }
__device__ __forceinline__ float hi2f(u32 v) { return __uint_as_float(v & 0xffff0000u); }
__device__ __forceinline__ float silu_f(float x) { return x * __builtin_amdgcn_rcpf(1.f + __expf(-x)); }
__device__ __forceinline__ float sigmoid_f(float x) { return __builtin_amdgcn_rcpf(1.f + __expf(-x)); }
__device__ __forceinline__ float softplus_f(float x) { const float e = __expf(x); return x > 20.f ? x : (e < 1e-4f ? e : __logf(1.f + e)); }
__device__ __forceinline__ float wave_sum(float v) {
#pragma unroll
  for (int o = 32; o > 0; o >>= 1) v += __shfl_xor(v, o, 64);
  return v;
}
__device__ __forceinline__ void unpack8(U4 v, float* f) {
  f[0] = lo2f(v.x); f[1] = hi2f(v.x); f[2] = lo2f(v.y); f[3] = hi2f(v.y);
  f[4] = lo2f(v.z); f[5] = hi2f(v.z); f[6] = lo2f(v.w); f[7] = hi2f(v.w);
}
__device__ __forceinline__ U4 pack8(const float* f) {
  U4 v; v.x = pack2(f[0], f[1]); v.y = pack2(f[2], f[3]); v.z = pack2(f[4], f[5]); v.w = pack2(f[6], f[7]);
  return v;
}
__device__ __forceinline__ f32x16 mfma32(bf16x8 a, bf16x8 b, f32x16 c) {
  return __builtin_amdgcn_mfma_f32_32x32x16_bf16(a, b, c, 0, 0, 0);
}
__device__ __forceinline__ f32x4 mfma16(bf16x8 a, bf16x8 b, f32x4 c) {
  return __builtin_amdgcn_mfma_f32_16x16x32_bf16(a, b, c, 0, 0, 0);
}
__device__ __forceinline__ bf16x8 as_bf16x8(U4 v) {
  return __builtin_bit_cast(bf16x8, v);
}
__device__ __forceinline__ bf16x8 ld_frag(const u16* p) { return as_bf16x8(*(const U4*)p); }

__device__ void transpose_tile(const float* __restrict__ src, int ld_src, u16* __restrict__ dst, int K, int n0,
                               int k0, int mapmode, const float* __restrict__ scale, char* smem) {
  float* tile = (float*)smem;
  const int tid = otid();
  const int nl = tid & 63;
  int n = n0 + nl;
  int col;
  if (mapmode == 0) col = n;
  else {
    if (n < 3072) col = n;
    else if (n < CDT) col = n + 16;
    else if (n < CDT + 16) col = 3072 + (n - CDT);
    else col = -1;
  }
  float v[32];
#pragma unroll
  for (int i = 0; i < 32; ++i) {
    int kk = (tid >> 6) + 4 * i;
    v[i] = (col >= 0) ? src[(size_t)(k0 + kk) * ld_src + col] : 0.f;
  }
  if (scale) {
#pragma unroll
    for (int i = 0; i < 32; ++i) v[i] *= scale[k0 + (tid >> 6) + 4 * i];
  }
#pragma unroll
  for (int i = 0; i < 32; ++i) tile[((tid >> 6) + 4 * i) * 65 + nl] = v[i];
  __syncthreads();
  {
    int nn = tid >> 2, kq = (tid & 3) * 32;
    u16* d = dst + (size_t)(n0 + nn) * K + k0 + kq;
#pragma unroll
    for (int h = 0; h < 4; ++h) {
      float f[8];
#pragma unroll
      for (int e = 0; e < 8; ++e) f[e] = tile[(kq + h * 8 + e) * 65 + nn];
      *(U4*)(d + h * 8) = pack8(f);
    }
  }
  __syncthreads();
}

__device__ void phase_weights(const Params& p, char* smem) {
  constexpr int NT_IN = (NP / 64) * 8, NT_PS = 128, NT_PA = 64, NT_PC = 64, NT_WO = 128;
  constexpr int PER_LAYER = NT_IN + NT_PS + NT_PA + NT_PC + NT_WO;
  const int half_ = __builtin_amdgcn_readfirstlane(otid512() >> 8);
  smem += half_ * HSMEM;
  for (int slot = blockIdx.x; slot < PER_LAYER; slot += gridDim.x) {
    int it = 2 * slot + half_;
    int l = it / PER_LAYER, r = it % PER_LAYER;
    if (r < NT_IN) {
      int nt = r / 8, kt = r % 8;
      transpose_tile(p.w_in + (size_t)l * D_ * NORIG, NORIG, p.WinT + (size_t)l * NP * D_, D_, nt * 64, kt * 128, 1,
                     p.norm_pre + l * D_, smem);
    } else if ((r -= NT_IN) < NT_PS) {
      int nt = r / 8, kt = r % 8;
      transpose_tile(p.p_ssm + (size_t)l * 1024 * 1024, 1024, p.PsT + (size_t)l * 1024 * 1024, 1024, nt * 64,
                     kt * 128, 0, nullptr, smem);
    } else if ((r -= NT_PS) < NT_PA) {
      int nt = r / 4, kt = r % 4;
      transpose_tile(p.p_attn + (size_t)l * 512 * 1024, 1024, p.PaT + (size_t)l * 1024 * 512, 512, nt * 64, kt * 128,
                     0, nullptr, smem);
    } else if ((r -= NT_PA) < NT_PC) {
      int nt = r / 4, kt = r % 4;
      transpose_tile(p.p_sc + (size_t)l * 512 * 1024, 1024, p.PcT + (size_t)l * 1024 * 512, 512, nt * 64, kt * 128, 0,
                     nullptr, smem);
    } else {
      r -= NT_PC;
      int nt = r / 8, kt = r % 8;
      transpose_tile(p.w_out + (size_t)l * 1024 * 1024, 1024, p.WoT + (size_t)l * 1024 * 1024, 1024, nt * 64,
                     kt * 128, 0, nullptr, smem);
    }
  }
  const int t512 = otid512();
  const int lane = t512 & 63, w = t512 >> 6;
  for (int it = blockIdx.x; it < T_ / 16; it += gridDim.x) {
    const int row = it * 16 + w * 2;
    const f32x4* xr = (const f32x4*)(p.x + (size_t)row * D_);
    f32x4 v[2][4];
    float ss0 = 0.f, ss1 = 0.f;
#pragma unroll
    for (int i = 0; i < 4; ++i) { v[0][i] = xr[i * 64 + lane]; v[1][i] = xr[256 + i * 64 + lane]; }
#pragma unroll
    for (int i = 0; i < 4; ++i) {
      ss0 += v[0][i].x * v[0][i].x + v[0][i].y * v[0][i].y + v[0][i].z * v[0][i].z + v[0][i].w * v[0][i].w;
      ss1 += v[1][i].x * v[1][i].x + v[1][i].y * v[1][i].y + v[1][i].z * v[1][i].z + v[1][i].w * v[1][i].w;
    }
    ss0 = wave_sum(ss0); ss1 = wave_sum(ss1);
    const float r0 = rsqrtf(ss0 * (1.f / D_) + EPS), r1 = rsqrtf(ss1 * (1.f / D_) + EPS);
#pragma unroll
    for (int i = 0; i < 4; ++i) {
      U2 o;
      o.x = pack2(v[0][i].x * r0, v[0][i].y * r0); o.y = pack2(v[0][i].z * r0, v[0][i].w * r0);
      *(U2*)(p.h + (size_t)row * D_ + (i * 64 + lane) * 4) = o;
      o.x = pack2(v[1][i].x * r1, v[1][i].y * r1); o.y = pack2(v[1][i].z * r1, v[1][i].w * r1);
      *(U2*)(p.h + (size_t)(row + 1) * D_ + (i * 64 + lane) * 4) = o;
    }
  }
}

#define LAS __attribute__((address_space(3)))
__device__ __forceinline__ int g_lds_byte(int r, int c) { const int st = (r >> 4) * 2 + (c >> 5), rr = r & 15, cc = c & 31, ob = rr * 64 + cc * 2; return st * 1024 + (ob ^ (((ob >> 9) & 1) << 5)); }
__device__ __forceinline__ void g_stage_rc(int b, int& R, int& C) { const int st = b / 1024, sb = b % 1024, swz = sb ^ (((sb >> 9) & 1) << 5); R = (st >> 1) * 16 + swz / 64; C = (st & 1) * 32 + (swz % 64) / 2; }
__device__ __forceinline__ void gemm_tile(const u16* __restrict__ A, int lda, const u16* __restrict__ Bt, int ldb,
                                          int K, f32x4 (&acc)[4][4], char* smem) {
  const int tid = otid(), lane = tid & 63, w = __builtin_amdgcn_readfirstlane(tid >> 6), wr = w >> 1, wc = w & 1;
  LAS unsigned char* lds = (LAS unsigned char*)smem;
  unsigned voA[4], voB[4];
#pragma unroll
  for (int i = 0; i < 4; ++i) {
    int R, C;
    g_stage_rc(tid * 16 + i * 4096, R, C);
    voA[i] = (unsigned)(R * lda + C) * 2u;
    voB[i] = (unsigned)(R * ldb + C) * 2u;
  }
  const unsigned ldsw = (unsigned)w * 1024u;
  const int fr = lane & 15, fq = lane >> 4;
  const int aoff = g_lds_byte(wr * 64 + fr, fq * 8), boff = g_lds_byte(wc * 64 + fr, fq * 8);
  const int nk = K / 64;
#define G_STAGE(buf, k0) do { _Pragma("unroll") for (int _i = 0; _i < 4; ++_i) { \
    __builtin_amdgcn_global_load_lds((const unsigned*)((const char*)A + (size_t)(k0) * 2 + voA[_i]), (LAS unsigned*)(lds + (buf) * 16384 + ldsw + _i * 4096), 16, 0, 0); \
    __builtin_amdgcn_global_load_lds((const unsigned*)((const char*)Bt + (size_t)(k0) * 2 + voB[_i]), (LAS unsigned*)(lds + 32768 + (buf) * 16384 + ldsw + _i * 4096), 16, 0, 0); } } while (0)
  G_STAGE(0, 0);
  for (int kt = 0; kt < nk; ++kt) {
    const int buf = kt & 1;
    asm volatile("s_waitcnt vmcnt(0)" ::: "memory");
    __syncthreads();
    if (kt + 1 < nk) {
      if (buf) G_STAGE(0, (kt + 1) * 64); else G_STAGE(1, (kt + 1) * 64);
    }
    const LAS unsigned char* as = lds + buf * 16384 + aoff;
    const LAS unsigned char* bs = lds + 32768 + buf * 16384 + boff;
#pragma unroll
    for (int ks = 0; ks < 2; ++ks) {
      bf16x8 af[4], bf[4];
#pragma unroll
      for (int mt = 0; mt < 4; ++mt) af[mt] = *(const LAS bf16x8*)(as + mt * 2048 + ks * 1024);
#pragma unroll
      for (int nt = 0; nt < 4; ++nt) bf[nt] = *(const LAS bf16x8*)(bs + nt * 2048 + ks * 1024);
#pragma unroll
      for (int mt = 0; mt < 4; ++mt)
#pragma unroll
        for (int nt = 0; nt < 4; ++nt) acc[mt][nt] = mfma16(bf[nt], af[mt], acc[mt][nt]);
    }
  }
#undef G_STAGE
  __syncthreads();
}

__device__ __forceinline__ void gemm_tile8(const u16* __restrict__ A, int lda, const u16* __restrict__ Bt, int ldb,
                                           int K, f32x4 (&acc)[4][4], char* smem) {
  const int tid = otid512(), lane = tid & 63, w = __builtin_amdgcn_readfirstlane(tid >> 6), wr = w >> 1, wc = w & 1;
  LAS unsigned char* lds = (LAS unsigned char*)smem;
  unsigned voA[2], voB[2];
#pragma unroll
  for (int i = 0; i < 2; ++i) {
    const int b = tid * 16 + i * 8192;
    const int R = b >> 7, cl = (b >> 4) & 7, C = (cl ^ (R & 7)) * 8;
    const int Rb = (R & 64) + ((R >> 2) & 3) * 16 + ((R >> 4) & 3) * 4 + (R & 3);
    voA[i] = (unsigned)(R * lda + C) * 2u;
    voB[i] = (unsigned)(Rb * ldb + C) * 2u;
  }
  const size_t a1step = (size_t)128 * lda * 2;
  const unsigned ldsw = (unsigned)w * 1024u;
  const int fr = lane & 15, fq = lane >> 4;
  const int arow = (wr >> 1) * 16384 + ((wr & 1) * 64 + fr) * 128;
  const int brow = 32768 + (wc * 64 + fr) * 128;
  const int ck0 = ((fq ^ (fr & 7)) << 4), ck1 = (((4 + fq) ^ (fr & 7)) << 4);
  const int nk = K / 64;
#define G8_STAGE(sb, k0) do { _Pragma("unroll") for (int _i = 0; _i < 2; ++_i) { \
    __builtin_amdgcn_global_load_lds((const unsigned*)((const char*)A + (size_t)(k0) * 2 + voA[_i]), (LAS unsigned*)(lds + (sb) + ldsw + _i * 8192), 16, 0, 0); \
    __builtin_amdgcn_global_load_lds((const unsigned*)((const char*)A + a1step + (size_t)(k0) * 2 + voA[_i]), (LAS unsigned*)(lds + (sb) + 16384 + ldsw + _i * 8192), 16, 0, 0); \
    __builtin_amdgcn_global_load_lds((const unsigned*)((const char*)Bt + (size_t)(k0) * 2 + voB[_i]), (LAS unsigned*)(lds + (sb) + 32768 + ldsw + _i * 8192), 16, 0, 0); } } while (0)
#define G8_COMPUTE(sb) do { \
    const LAS unsigned char* as_ = lds + (sb) + arow; const LAS unsigned char* bs_ = lds + (sb) + brow; \
    _Pragma("unroll") for (int ks = 0; ks < 2; ++ks) { \
      const int ck = ks ? ck1 : ck0; \
      bf16x8 af[4], bf[4]; \
      _Pragma("unroll") for (int mt = 0; mt < 4; ++mt) af[mt] = *(const LAS bf16x8*)(as_ + mt * 2048 + ck); \
      _Pragma("unroll") for (int nt = 0; nt < 4; ++nt) bf[nt] = *(const LAS bf16x8*)(bs_ + nt * 2048 + ck); \
      _Pragma("unroll") for (int mt = 0; mt < 4; ++mt) _Pragma("unroll") for (int nt = 0; nt < 4; ++nt) acc[mt][nt] = mfma16(bf[nt], af[mt], acc[mt][nt]); } } while (0)
  G8_STAGE(0, 0); G8_STAGE(49152, 64);
  int cur = 0, nxt2 = 2 * 49152;
  for (int kt = 0; kt < nk - 1; ++kt) {
    asm volatile("s_waitcnt vmcnt(6)" ::: "memory");
    __builtin_amdgcn_s_barrier();
    asm volatile("" ::: "memory");
    if (kt + 2 < nk) G8_STAGE(nxt2, (kt + 2) * 64);
    G8_COMPUTE(cur);
    cur = (cur == 2 * 49152) ? 0 : cur + 49152;
    nxt2 = (nxt2 == 2 * 49152) ? 0 : nxt2 + 49152;
  }
  asm volatile("s_waitcnt vmcnt(0)" ::: "memory");
  __builtin_amdgcn_s_barrier();
  asm volatile("" ::: "memory");
  G8_COMPUTE(cur);
#undef G8_STAGE
#undef G8_COMPUTE
  __syncthreads();
}

__device__ __forceinline__ void zero_acc(f32x4 (&acc)[4][4]) {
#pragma unroll
  for (int a = 0; a < 4; ++a)
#pragma unroll
    for (int b = 0; b < 4; ++b) acc[a][b] = f32x4{0.f, 0.f, 0.f, 0.f};
}

namespace pg8 {
constexpr int BM = 256, BK = 64, HALF = 128, HTB = HALF * BK * 2, NXCD = 8, WGM = 8;
__device__ __forceinline__ int lds_byte(int r, int c) { const int st = (r >> 4) * 2 + (c >> 5), rr = r & 15, cc = c & 31, ob = rr * 64 + cc * 2; return st * 1024 + (ob ^ (((ob >> 9) & 1) << 5)); }
__device__ __forceinline__ void stage_rc(int b, int& R, int& C) { const int st = b / 1024, sb = b % 1024, swz = sb ^ (((sb >> 9) & 1) << 5); R = (st >> 1) * 16 + swz / 64; C = (st & 1) * 32 + (swz % 64) / 2; }
__device__ __forceinline__ int perm32(int rho) { const int n = rho >> 4, i = rho & 15; return 8 * (i >> 2) + 4 * n + (i & 3); }
struct Unit { int pm, pn; const char* a; const char* b; int mode; int gcol; };
struct StaticOrder {
  int nM, nN, nwg, G, c;
  __device__ void init(int M, int N, int G_, int c_) { nM = M / BM; nN = N / BM; nwg = nM * nN; G = G_; c = c_; }
  __device__ bool next(int i, int& pm, int& pn) const {
    const long L = (long)i * G + c; if (L >= nwg) return false;
    int wgid = (int)L; { const int q = nwg / NXCD, r = nwg % NXCD, xcd = wgid % NXCD, off = wgid / NXCD; wgid = (xcd < r ? xcd * (q + 1) : r * (q + 1) + (xcd - r) * q) + off; }
    const int nig = WGM * nN, gid = wgid / nig, fm = gid * WGM, gsz = (nM - fm) < WGM ? (nM - fm) : WGM;
    pm = fm + ((wgid % nig) % gsz); pn = (wgid % nig) / gsz; return true;
  }
};
struct Sched {
  int kind; StaticOrder so; const char* gA; const char* gB; size_t tstep; int mode0;
  int n; Unit u0, u1;
  __device__ __forceinline__ bool next(int i, Unit& u) const {
    if (kind == 0) {
      int pm, pn; if (!so.next(i, pm, pn)) return false;
      u.pm = pm; u.pn = pn; u.a = gA + (size_t)pm * tstep; u.b = gB + (size_t)pn * tstep; u.mode = mode0; u.gcol = 0; return true;
    }
    if (i >= n) return false;
    u = (i == 0) ? u0 : u1; return true;
  }
};
struct Epi {
  u16* O16; int ld16; u16* T16; int ldt; const u16* gate; int ldg;
  __device__ __forceinline__ void operator()(const f32x4 (&acc)[2][2][4][2], const Unit& u, int wr, int wc, int fr, int fq) const {
    const int row0 = u.pm * BM + wr * 64 + fr, col0 = u.pn * BM + wc * 64 + 16 * fq;
    const int mode = u.mode;
    if (mode == 5) return;
#pragma unroll
    for (int ai = 0; ai < 2; ++ai)
#pragma unroll
      for (int m = 0; m < 4; ++m) {
        const size_t row = (size_t)(row0 + ai * HALF + m * 16);
#pragma unroll
        for (int bj = 0; bj < 2; ++bj) {
          f32x4 v0 = acc[ai][bj][m][0], v1 = acc[ai][bj][m][1];
          const int col = col0 + bj * 8;
          if (mode != 0) {
            U4 gv = *(const U4*)(gate + row * ldg + u.gcol + col);
            float g8[8];
            unpack8(gv, g8);
            v0[0] *= sigmoid_f(g8[0]); v0[1] *= sigmoid_f(g8[1]); v0[2] *= sigmoid_f(g8[2]); v0[3] *= sigmoid_f(g8[3]);
            v1[0] *= sigmoid_f(g8[4]); v1[1] *= sigmoid_f(g8[5]); v1[2] *= sigmoid_f(g8[6]); v1[3] *= sigmoid_f(g8[7]);
            if (mode == 3) {
              float t8[8];
              unpack8(*(const U4*)(T16 + row * ldt + col), t8);
              v0[0] += t8[0]; v0[1] += t8[1]; v0[2] += t8[2]; v0[3] += t8[3];
              v1[0] += t8[4]; v1[1] += t8[5]; v1[2] += t8[6]; v1[3] += t8[7];
            }
          }
          U4 w; w.x = cvt_pk_bf16(v0[0], v0[1]); w.y = cvt_pk_bf16(v0[2], v0[3]); w.z = cvt_pk_bf16(v1[0], v1[1]); w.w = cvt_pk_bf16(v1[2], v1[3]);
          u16* dst = (mode == 2) ? (T16 + row * ldt + col) : (O16 + paddr(row, col));
#ifdef NT_STORE
          __builtin_nontemporal_store(w, (U4*)dst);
#else
          *(U4*)dst = w;
#endif
        }
      }
  }
};
__device__ __forceinline__ void gemm_phase(LAS unsigned char* lds, int K, const Sched& S, const Epi& E) {
  const int tid = otid512(), wid = __builtin_amdgcn_readfirstlane(tid >> 6), lane = tid & 63, wr = wid >> 2, wc = wid & 3, fr = lane & 15, fq = lane >> 4;
  const int nt = K / BK;
  unsigned voffA[2], voffB[2];
#pragma unroll
  for (int i = 0; i < 2; ++i) {
    const int b_ = tid * 16 + i * 8192; const int R = b_ >> 7; const int C = ((((b_ >> 4) & 7) ^ (R & 7)) * 8);
    const int Rb = (R >> 5) * 64 + ((R >> 2) & 3) * 16 + ((R >> 4) & 1) * 4 + (R & 3);
    voffA[i] = (unsigned)(R * K + C) * 2u; voffB[i] = (unsigned)(Rb * K + C) * 2u; }
  const size_t kstep = (size_t)(BK * 2);
  const size_t hstep = (size_t)HALF * K * 2;
  const size_t hstepB = (size_t)8 * K * 2;
  const unsigned ldsw = (unsigned)wid * 1024u;
  const int aoff = (wr * 64 + fr) * 128, boff = (wc * 32 + fr) * 128;
  const int ck0 = ((fq ^ (fr & 7)) << 4), ck1 = (((4 + fq) ^ (fr & 7)) << 4);
#define PG8_SA(b, h) (((b) * 2 + (h)) * HTB)
#define PG8_SB(b, h) ((4 + (b) * 2 + (h)) * HTB)
#define PG8_STAGE(bufoff, gbase, voff) do { _Pragma("unroll") for (int _i = 0; _i < 2; ++_i) \
    __builtin_amdgcn_global_load_lds((const unsigned*)((const char*)(gbase) + (voff)[_i]), (LAS unsigned*)(lds + (bufoff) + ldsw + _i * 8192), 16, 0, 0); } while (0)
#define PG8_LDA(dst, b, h) do { _Pragma("unroll") for (int m = 0; m < 4; ++m) _Pragma("unroll") for (int k = 0; k < 2; ++k) dst[m][k] = *(const LAS bf16x8*)(lds + PG8_SA(b, h) + aoff + m * 2048 + (k ? ck1 : ck0)); } while (0)
#define PG8_LDB(dst, b, h) do { _Pragma("unroll") for (int n = 0; n < 2; ++n) _Pragma("unroll") for (int k = 0; k < 2; ++k) dst[n][k] = *(const LAS bf16x8*)(lds + PG8_SB(b, h) + boff + n * 2048 + (k ? ck1 : ck0)); } while (0)
#define PG8_MMA(ai, bj, At, Bt) do { __builtin_amdgcn_s_setprio(1); _Pragma("unroll") for (int m = 0; m < 4; ++m) _Pragma("unroll") for (int n = 0; n < 2; ++n) _Pragma("unroll") for (int k = 0; k < 2; ++k) \
    acc[ai][bj][m][n] = __builtin_amdgcn_mfma_f32_16x16x32_bf16(Bt[n][k], At[m][k], acc[ai][bj][m][n], 0, 0, 0); __builtin_amdgcn_s_setprio(0); } while (0)
#define PG8_WAIT_V(n) asm volatile("s_waitcnt vmcnt(" #n ")" ::: "memory")
#define PG8_WAIT_L(n) asm volatile("s_waitcnt lgkmcnt(" #n ")" ::: "memory")
#define PG8_BAR __builtin_amdgcn_s_barrier()
#define PG8_SCHED __builtin_amdgcn_sched_barrier(0)
  Unit cur, nxt; int ui = 0;
  if (!S.next(0, cur)) return;
  f32x4 acc[2][2][4][2];
#pragma unroll
  for (int a = 0; a < 2; ++a)
#pragma unroll
    for (int b = 0; b < 2; ++b)
#pragma unroll
      for (int m = 0; m < 4; ++m)
#pragma unroll
        for (int n = 0; n < 2; ++n) acc[a][b][m][n] = (f32x4){0.f, 0.f, 0.f, 0.f};
  bf16x8 At[4][2], B0[2][2], B1[2][2];
  const char* cA = cur.a; const char* cB = cur.b;
  PG8_STAGE(PG8_SB(0, 0), cB, voffB); PG8_STAGE(PG8_SA(0, 0), cA, voffA); PG8_STAGE(PG8_SB(0, 1), cB + hstepB, voffB); PG8_STAGE(PG8_SA(0, 1), cA + hstep, voffA);
  if (wr == 1) PG8_BAR;
  PG8_WAIT_V(4); PG8_BAR;
  PG8_STAGE(PG8_SB(1, 0), cB + kstep, voffB); PG8_STAGE(PG8_SA(1, 0), cA + kstep, voffA); PG8_STAGE(PG8_SB(1, 1), cB + hstepB + kstep, voffB);
  PG8_WAIT_V(6); PG8_BAR;
  for (;;) {
    const bool has_next = S.next(ui + 1, nxt);
    const char* nA = has_next ? nxt.a : cA; const char* nB = has_next ? nxt.b : cB;
    for (int t = 0; t < nt; t += 2) {
      const bool last = (t == nt - 2);
      const char* a1 = cA + (size_t)(t + 1) * kstep;
      const char* a2 = last ? nA : cA + (size_t)(t + 2) * kstep; const char* b2 = last ? nB : cB + (size_t)(t + 2) * kstep;
      const char* a3 = a2 + kstep; const char* b3 = b2 + kstep;
      PG8_LDB(B0, 0, 0); PG8_SCHED; PG8_LDA(At, 0, 0); PG8_STAGE(PG8_SA(1, 1), a1 + hstep, voffA);
      PG8_WAIT_L(8); PG8_BAR; PG8_WAIT_L(0); PG8_MMA(0, 0, At, B0); PG8_BAR; PG8_SCHED;
      PG8_LDB(B1, 0, 1); PG8_STAGE(PG8_SB(0, 0), b2, voffB);
      PG8_BAR; PG8_WAIT_L(0); PG8_MMA(0, 1, At, B1); PG8_BAR;
      PG8_LDA(At, 0, 1); PG8_STAGE(PG8_SA(0, 0), a2, voffA);
      PG8_BAR; PG8_WAIT_L(0); PG8_MMA(1, 0, At, B0); PG8_BAR; PG8_SCHED;
      PG8_STAGE(PG8_SB(0, 1), b2 + hstepB, voffB);
      PG8_WAIT_V(6); PG8_BAR; PG8_MMA(1, 1, At, B1); PG8_BAR;
      PG8_LDB(B0, 1, 0); PG8_SCHED; PG8_LDA(At, 1, 0); PG8_STAGE(PG8_SA(0, 1), a2 + hstep, voffA);
      PG8_WAIT_L(8); PG8_BAR; PG8_WAIT_L(0); PG8_MMA(0, 0, At, B0); PG8_BAR; PG8_SCHED;
      PG8_LDB(B1, 1, 1); PG8_STAGE(PG8_SB(1, 0), b3, voffB);
      PG8_BAR; PG8_WAIT_L(0); PG8_MMA(0, 1, At, B1); PG8_BAR;
      PG8_LDA(At, 1, 1); PG8_STAGE(PG8_SA(1, 0), a3, voffA);
      PG8_BAR; PG8_WAIT_L(0); PG8_MMA(1, 0, At, B0); PG8_BAR; PG8_SCHED;
      PG8_STAGE(PG8_SB(1, 1), b3 + hstepB, voffB);
      PG8_WAIT_V(6); PG8_BAR; PG8_MMA(1, 1, At, B1); PG8_BAR;
    }
    E(acc, cur, wr, wc, fr, fq);
    if (!has_next) break;
#pragma unroll
    for (int a = 0; a < 2; ++a)
#pragma unroll
      for (int b = 0; b < 2; ++b)
#pragma unroll
        for (int m = 0; m < 4; ++m)
#pragma unroll
          for (int n = 0; n < 2; ++n) acc[a][b][m][n] = (f32x4){0.f, 0.f, 0.f, 0.f};
    cur = nxt; cA = nA; cB = nB; ++ui;
  }
  PG8_WAIT_V(0);
  if (wr == 0) PG8_BAR;
  PG8_BAR;
#undef PG8_SA
#undef PG8_SB
#undef PG8_STAGE
#undef PG8_LDA
#undef PG8_LDB
#undef PG8_MMA
#undef PG8_WAIT_V
#undef PG8_WAIT_L
#undef PG8_BAR
#undef PG8_SCHED
}
}

__device__ void merge_tile8(const Params& p, int layer, int tile, char* smem) {
  const int mt_ = tile % (TC / 256), nt_ = tile / (TC / 256);
  const int t512 = otid512(), lane = t512 & 63, w = t512 >> 6, wr = w >> 1, wc = w & 1;
  f32x4 acc[4][4], tot[4][4];
  zero_acc(tot);
#pragma unroll 1
  for (int br = 0; br < 3; ++br) {
    zero_acc(acc);
    const u16* A; const u16* Bt; int K;
    if (br == 0) { A = p.yssm + (size_t)mt_ * 256 * 1024; Bt = p.PsT + (size_t)layer * 1024 * 1024 + (size_t)nt_ * 128 * 1024; K = 1024; }
    else if (br == 1) { A = p.yattn + (size_t)mt_ * 256 * 512; Bt = p.PaT + (size_t)layer * 1024 * 512 + (size_t)nt_ * 128 * 512; K = 512; }
    else { A = p.ysc + (size_t)mt_ * 256 * 512; Bt = p.PcT + (size_t)layer * 1024 * 512 + (size_t)nt_ * 128 * 512; K = 512; }
    gemm_tile8(A, K, Bt, K, K, acc, smem);
#pragma unroll
    for (int mt = 0; mt < 4; ++mt) {
      const int m = mt_ * 256 + wr * 64 + mt * 16 + (lane & 15);
      const int n = nt_ * 128 + wc * 64 + (lane >> 4) * 16;
      const u16* gp = p.proj + paddr((size_t)m, CM + br * 1024 + n);
      float g16[16];
      unpack8(*(const U4*)gp, g16);
      unpack8(*(const U4*)(gp + 8), g16 + 8);
#pragma unroll
      for (int nt = 0; nt < 4; ++nt)
#pragma unroll
        for (int j = 0; j < 4; ++j) tot[mt][nt][j] += sigmoid_f(g16[nt * 4 + j]) * acc[mt][nt][j];
    }
  }
#pragma unroll
  for (int mt = 0; mt < 4; ++mt) {
    const int m = mt_ * 256 + wr * 64 + mt * 16 + (lane & 15);
    const int n = nt_ * 128 + wc * 64 + (lane >> 4) * 16;
    U4 o0, o1;
    o0.x = pack2(tot[mt][0][0], tot[mt][0][1]); o0.y = pack2(tot[mt][0][2], tot[mt][0][3]);
    o0.z = pack2(tot[mt][1][0], tot[mt][1][1]); o0.w = pack2(tot[mt][1][2], tot[mt][1][3]);
    o1.x = pack2(tot[mt][2][0], tot[mt][2][1]); o1.y = pack2(tot[mt][2][2], tot[mt][2][3]);
    o1.z = pack2(tot[mt][3][0], tot[mt][3][1]); o1.w = pack2(tot[mt][3][2], tot[mt][3][3]);
    u16* dp = p.Pa + (size_t)m * 1024 + n;
    *(U4*)dp = o0; *(U4*)(dp + 8) = o1;
  }
}

__device__ void wout_tile8(const Params& p, int layer, int tile, char* smem) {
  const int mt_ = tile % (TC / 256), nt_ = tile / (TC / 256);
  const int t512 = otid512(), lane = t512 & 63, w = t512 >> 6, wr = w >> 1, wc = w & 1;
  f32x4 acc[4][4];
  zero_acc(acc);
  gemm_tile8(p.Pa + (size_t)mt_ * 256 * 1024, 1024, p.WoT + (size_t)layer * 1024 * 1024 + (size_t)nt_ * 128 * 1024,
             1024, 1024, acc, smem);
#pragma unroll
  for (int mt = 0; mt < 4; ++mt) {
    const int m = mt_ * 256 + wr * 64 + mt * 16 + (lane & 15);
    const int n = nt_ * 128 + wc * 64 + (lane >> 4) * 16;
    U4 o0, o1;
    o0.x = pack2(acc[mt][0][0], acc[mt][0][1]); o0.y = pack2(acc[mt][0][2], acc[mt][0][3]);
    o0.z = pack2(acc[mt][1][0], acc[mt][1][1]); o0.w = pack2(acc[mt][1][2], acc[mt][1][3]);
    o1.x = pack2(acc[mt][2][0], acc[mt][2][1]); o1.y = pack2(acc[mt][2][2], acc[mt][2][3]);
    o1.z = pack2(acc[mt][3][0], acc[mt][3][1]); o1.w = pack2(acc[mt][3][2], acc[mt][3][3]);
    u16* dp = p.outA + (size_t)m * 1024 + n;
    *(U4*)dp = o0; *(U4*)(dp + 8) = o1;
  }
}

__device__ void resid_item(const Params& p, int layer, int ch, int it) {
  const int t512 = otid512();
  const int lane = t512 & 63, w = t512 >> 6;
  const int rl = it * 8 + w;
  const size_t rg = (size_t)ch * TC + rl;
  const float* xs = (layer == 0 ? p.x : p.out) + rg * D_;
  float* xd = p.out + rg * D_;
  const float* wp = p.norm_post + layer * D_;
  f32x4 o[4], xv[4], wv[4];
  float ps = 0.f;
#pragma unroll
  for (int i = 0; i < 4; ++i) {
    int c = (i * 64 + lane) * 4;
    U2 pa = *(const U2*)(p.outA + (size_t)rl * D_ + c);
    xv[i] = *(const f32x4*)(xs + c);
    wv[i] = *(const f32x4*)(wp + c);
    o[i].x = lo2f(pa.x); o[i].y = hi2f(pa.x); o[i].z = lo2f(pa.y); o[i].w = hi2f(pa.y);
    ps += o[i].x * o[i].x + o[i].y * o[i].y + o[i].z * o[i].z + o[i].w * o[i].w;
  }
  ps = wave_sum(ps);
  const float rstd = rsqrtf(ps * (1.f / D_) + EPS);
  f32x4 v[4];
  float ss = 0.f;
#pragma unroll
  for (int i = 0; i < 4; ++i) {
    int c = (i * 64 + lane) * 4;
    v[i] = xv[i] + o[i] * rstd * wv[i];
    *(f32x4*)(xd + c) = v[i];
    ss += v[i].x * v[i].x + v[i].y * v[i].y + v[i].z * v[i].z + v[i].w * v[i].w;
  }
  if (layer == 0) {
    ss = wave_sum(ss);
    float r2 = rsqrtf(ss * (1.f / D_) + EPS);
#pragma unroll
    for (int i = 0; i < 4; ++i) {
      U2 ov;
      ov.x = pack2(v[i].x * r2, v[i].y * r2);
      ov.y = pack2(v[i].z * r2, v[i].w * r2);
      *(U2*)(p.h + rg * D_ + (i * 64 + lane) * 4) = ov;
    }
  }
}

__device__ __forceinline__ void dt_cs_setup(const Params& p, int layer, size_t R0, int g, float* cs_s, float* dt_s,
                                            float& cs_last_out) {
  const int lane = otid() & 63, w = otid() >> 6;
  const int hd = g * 4 + w;
  const float bias = p.dt_bias[layer * 16 + hd];
  const float aneg = -__expf(p.a_log[layer * 16 + hd]);
  float d0 = softplus_f(bf2f(p.proj[paddr(R0 + lane, CDT + hd)]) + bias);
  float d1 = softplus_f(bf2f(p.proj[paddr(R0 + 64 + lane, CDT + hd)]) + bias);
  float c0 = d0 * aneg, c1 = d1 * aneg;
#pragma unroll
  for (int o = 1; o < 64; o <<= 1) {
    float t0 = __shfl_up(c0, o, 64), t1 = __shfl_up(c1, o, 64);
    if (lane >= o) { c0 += t0; c1 += t1; }
  }
  float tot0 = __shfl(c0, 63, 64);
  c1 += tot0;
  cs_last_out = __shfl(c1, 63, 64);
  cs_s[w * 128 + lane] = c0;
  cs_s[w * 128 + 64 + lane] = c1;
  dt_s[w * 128 + lane] = d0;
  dt_s[w * 128 + 64 + lane] = d1;
}

template <int NT>
__device__ __forceinline__ void conv_load(const u16* proj, size_t row0, int col, int tin0, U4 (&rows)[NT + 3]) {
#pragma unroll
  for (int i = 0; i < NT + 3; ++i) {
    const bool ok = (tin0 + i - 3) >= 0;
    U4 v = *(const U4*)(proj + paddr(ok ? row0 + i - 3 : row0, col));
    rows[i] = ok ? v : U4{0u, 0u, 0u, 0u};
  }
}
template <int NT, class F>
__device__ __forceinline__ void conv_compute(const U4 (&rows)[NT + 3], const float* cw, const float* cb, F&& emit) {
  f32x4 w0[4], w1[4];
#pragma unroll
  for (int k = 0; k < 4; ++k) { w0[k] = *(const f32x4*)(cw + k * 2048); w1[k] = *(const f32x4*)(cw + k * 2048 + 4); }
  const f32x4 b0 = *(const f32x4*)cb, b1 = *(const f32x4*)(cb + 4);
  float win[4][8];
  unpack8(rows[0], win[0]); unpack8(rows[1], win[1]); unpack8(rows[2], win[2]);
#pragma unroll
  for (int t = 0; t < NT; ++t) {
    unpack8(rows[t + 3], win[(t + 3) & 3]);
    float a8[8] = {b0.x, b0.y, b0.z, b0.w, b1.x, b1.y, b1.z, b1.w};
#pragma unroll
    for (int k = 0; k < 4; ++k) {
      const float* v8 = win[(t + k) & 3];
      a8[0] += w0[k].x * v8[0]; a8[1] += w0[k].y * v8[1]; a8[2] += w0[k].z * v8[2]; a8[3] += w0[k].w * v8[3];
      a8[4] += w1[k].x * v8[4]; a8[5] += w1[k].y * v8[5]; a8[6] += w1[k].z * v8[6]; a8[7] += w1[k].w * v8[7];
    }
#pragma unroll
    for (int e = 0; e < 8; ++e) a8[e] = silu_f(a8[e]);
    emit(t, a8);
  }
}

__device__ void ssd_passA(const Params& p, int layer, int it, char* smem) {
  const int tid = otid(), lane = tid & 63, w = __builtin_amdgcn_readfirstlane(tid >> 6);
  const int hp = it & 1, g = (it >> 1) & 3, c = (it >> 3) & 31, bl = it >> 8;
  const size_t R0 = (size_t)bl * S_ + c * 128;
  u16* Bt = (u16*)smem;
  u16* Xt = Bt + 128 * 136;
  float* cs_s = (float*)(smem + 69632);
  float* wg_s = cs_s + 256;
  const int hd0 = g * 4 + hp * 2;
  if (w < 2) {
    const int hd = hd0 + w;
    const float bias = p.dt_bias[layer * 16 + hd];
    const float aneg = -__expf(p.a_log[layer * 16 + hd]);
    float d0 = softplus_f(bf2f(p.proj[paddr(R0 + lane, CDT + hd)]) + bias);
    float d1 = softplus_f(bf2f(p.proj[paddr(R0 + 64 + lane, CDT + hd)]) + bias);
    float c0 = d0 * aneg, c1 = d1 * aneg;
#pragma unroll
    for (int o = 1; o < 64; o <<= 1) {
      float t0 = __shfl_up(c0, o, 64), t1 = __shfl_up(c1, o, 64);
      if (lane >= o) { c0 += t0; c1 += t1; }
    }
    c1 += __shfl(c0, 63, 64);
    const float cs_last = __shfl(c1, 63, 64);
    wg_s[w * 128 + lane] = d0 * __expf(cs_last - c0);
    wg_s[w * 128 + 64 + lane] = d1 * __expf(cs_last - c1);
    if (lane == 0) p.dec[((size_t)bl * 32 + c) * 16 + hd] = __expf(cs_last);
  }
  const float* cw = p.ssm_conv_w + (size_t)layer * 4 * 2048;
  const float* cb = p.ssm_conv_b + (size_t)layer * 2048;
  {
    const int chunk = tid & 31, tg = tid >> 5;
    const int chn = (chunk < 16) ? (hd0 * 64 + chunk * 8) : (1024 + g * 128 + (chunk - 16) * 8);
    u16* dst = (chunk < 16) ? (Xt + (chunk * 8) * 136) : (Bt + ((chunk - 16) * 8) * 136);
    const int t0 = tg * 16;
    const int chunkc = tid & 7, tgc = tid >> 3;
    const int chnc = 1536 + g * 128 + (hp * 8 + chunkc) * 8;
    const int t0c = tgc * 4;
    U4 rxb[19], rcc[7];
    conv_load<16>(p.proj, R0 + t0, CX + chn, c * 128 + t0, rxb);
    conv_load<4>(p.proj, R0 + t0c, CX + chnc, c * 128 + t0c, rcc);
    u16* xo = p.xc + (R0 + t0) * 2048 + chn;
    conv_compute<16>(rxb, cw + chn, cb + chn, [&](int t, const float* a8) {
      U4 ov = pack8(a8);
      *(U4*)(xo + (size_t)t * 2048) = ov;
      const int tok = t0 + t;
      u16* d = dst + ((((tok >> 3) ^ (chunk & 15)) << 3) | (tok & 7));
      d[0 * 136] = (u16)(ov.x & 0xffff); d[1 * 136] = (u16)(ov.x >> 16);
      d[2 * 136] = (u16)(ov.y & 0xffff); d[3 * 136] = (u16)(ov.y >> 16);
      d[4 * 136] = (u16)(ov.z & 0xffff); d[5 * 136] = (u16)(ov.z >> 16);
      d[6 * 136] = (u16)(ov.w & 0xffff); d[7 * 136] = (u16)(ov.w >> 16);
    });
    u16* xoc = p.xc + (R0 + t0c) * 2048 + chnc;
    conv_compute<4>(rcc, cw + chnc, cb + chnc, [&](int t, const float* a8) {
      *(U4*)(xoc + (size_t)t * 2048) = pack8(a8);
    });
  }
  __syncthreads();
#pragma unroll
  for (int i = 0; i < 4; ++i) {
    const int q = tid + 256 * i;
    const int row = q >> 3, grp = q & 7, sw = (row >> 3) & 15;
    const U4 a = *(const U4*)(Xt + row * 136 + (((2 * grp) ^ sw) << 3));
    const U4 b = *(const U4*)(Xt + row * 136 + (((2 * grp + 1) ^ sw) << 3));
    const size_t sx = ((size_t)bl * 32 + c) * 16 + hd0 + (row >> 6);
    u16* d = p.xT + sx * 8192 + (size_t)(row & 63) * 128 + grp * 16;
    U4 o0, o1;
    o0.x = a.x; o0.y = a.y; o0.z = b.x; o0.w = b.y;
    o1.x = a.z; o1.y = a.w; o1.z = b.z; o1.w = b.w;
    *(U4*)d = o0; *(U4*)(d + 8) = o1;
  }
  const int hl = w >> 1, nh = w & 1;
  const int r31 = lane & 31, hh = lane >> 5;
  f32x16 acc[2][2];
#pragma unroll
  for (int a = 0; a < 2; ++a)
#pragma unroll
    for (int b = 0; b < 2; ++b)
#pragma unroll
      for (int r = 0; r < 16; ++r) acc[a][b][r] = 0.f;
#pragma unroll 2
  for (int s = 0; s < 8; ++s) {
    float wv[8];
#pragma unroll
    for (int e = 0; e < 8; ++e) wv[e] = wg_s[hl * 128 + s * 16 + hh * 8 + e];
    bf16x8 xf[2];
#pragma unroll
    for (int pt = 0; pt < 2; ++pt) {
      const int xr = hl * 64 + pt * 32 + r31;
      U4 raw = *(const U4*)(Xt + xr * 136 + (((s * 2 + hh) ^ ((xr >> 3) & 15)) << 3));
      float v8[8];
      unpack8(raw, v8);
#pragma unroll
      for (int e = 0; e < 8; ++e) v8[e] *= wv[e];
      xf[pt] = as_bf16x8(pack8(v8));
    }
#pragma unroll
    for (int nt = 0; nt < 2; ++nt) {
      const int br = nh * 64 + nt * 32 + (((r31 >> 2) & 1) * 16 + (r31 & 3) + 4 * (r31 >> 3));
      bf16x8 bfr = ld_frag(Bt + br * 136 + (((s * 2 + hh) ^ ((br >> 3) & 15)) << 3));
#pragma unroll
      for (int pt = 0; pt < 2; ++pt) acc[nt][pt] = mfma32(bfr, xf[pt], acc[nt][pt]);
    }
  }
  {
    const size_t sidx = ((size_t)bl * 32 + c) * 16 + hd0 + hl;
#pragma unroll
    for (int nt = 0; nt < 2; ++nt)
#pragma unroll
      for (int pt = 0; pt < 2; ++pt)
#pragma unroll
        for (int h2 = 0; h2 < 2; ++h2) {
          U4 v;
          v.x = pack2(acc[nt][pt][h2 * 8 + 0], acc[nt][pt][h2 * 8 + 1]);
          v.y = pack2(acc[nt][pt][h2 * 8 + 2], acc[nt][pt][h2 * 8 + 3]);
          v.z = pack2(acc[nt][pt][h2 * 8 + 4], acc[nt][pt][h2 * 8 + 5]);
          v.w = pack2(acc[nt][pt][h2 * 8 + 6], acc[nt][pt][h2 * 8 + 7]);
          *(U4*)(p.stloc + sidx * 8192 + (size_t)(pt * 32 + r31) * 128 + nh * 64 + nt * 32 + hh * 16 + h2 * 8) = v;
        }
  }
  __syncthreads();
}

__device__ void ssd_scan_item(const Params& p, int it) {
  const int q = it * 512 + otid512();
  const int e2 = q & 4095, bh = q >> 12;
  const int bl = bh >> 4, hd = bh & 15;
  u32 lv[32];
  float dv[32];
#pragma unroll
  for (int c = 0; c < 32; ++c) {
    const size_t sidx = ((size_t)bl * 32 + c) * 16 + hd;
    lv[c] = *(const u32*)(p.stloc + sidx * 8192 + e2 * 2);
    dv[c] = p.dec[sidx];
  }
  float s0 = 0.f, s1 = 0.f;
#pragma unroll
  for (int c = 0; c < 32; ++c) {
    const size_t sidx = ((size_t)bl * 32 + c) * 16 + hd;
    *(u32*)(p.prev + sidx * 8192 + e2 * 2) = pack2(s0, s1);
    s0 = s0 * dv[c] + lo2f(lv[c]);
    s1 = s1 * dv[c] + hi2f(lv[c]);
  }
}

__device__ void ssd_passC(const Params& p, int layer, int it, char* smem) {
  const int tid = otid(), lane = tid & 63, w = __builtin_amdgcn_readfirstlane(tid >> 6);
  const int lh = it & 1, g = (it >> 1) & 3, c = (it >> 3) & 31, bl = it >> 8;
  const size_t R0 = (size_t)bl * S_ + c * 128;
  float* cs_s = (float*)smem;
  float* dt_s = cs_s + 512;
  float* ssq_s = (float*)(smem + 4096);
  const int strip = w >> 1, hp = w & 1;
  const int ntile = lh * 2 + strip + 1;
  const int r31 = lane & 31, hh = lane >> 5;
  const int l = (ntile - 1) * 32 + r31;
  bf16x8 cf[8];
  {
    const u16* cp = p.xc + (R0 + l) * 2048 + 1536 + g * 128 + hh * 8;
#pragma unroll
    for (int s = 0; s < 8; ++s) cf[s] = ld_frag(cp + s * 16);
  }
  {
    float dummy;
    dt_cs_setup(p, layer, R0, g, cs_s, dt_s, dummy);
  }
  __syncthreads();
  f32x16 gacc[4];
#pragma unroll
  for (int st = 0; st < 4; ++st) {
#pragma unroll
    for (int r = 0; r < 16; ++r) gacc[st][r] = 0.f;
    if (st < ntile) {
      const u16* bp = p.xc + (R0 + st * 32 + r31) * 2048 + 1024 + g * 128 + hh * 8;
#pragma unroll
      for (int s = 0; s < 8; ++s) gacc[st] = mfma32(ld_frag(bp + s * 16), cf[s], gacc[st]);
    }
  }
  U4* ypk = (U4*)(smem + 8192) + tid;
  float ssq = 0.f;
  const u16* xrow = p.xc + (R0 + l) * 2048;
  u16* yrow = p.yssm + (R0 + l) * 1024;
  const int pir = ((r31 >> 2) & 1) * 16 + (r31 & 3) + 4 * (r31 >> 3);
  const int loff = pir * 128 + hh * 8;
  const int xoff = pir * 128 + hh * 8;
#pragma unroll 1
  for (int j = 0; j < 2; ++j) {
    int hd = g * 4 + hp * 2 + j;
    asm volatile("" : "+s"(hd));
    const size_t sb = (((size_t)bl * 32 + c) * 16 + hd) * 8192;
    const u16* prevj = p.prev + sb;
    const u16* xTj = p.xT + sb;
    const float* csj = cs_s + (hd & 3) * 128;
    const float* dtj = dt_s + (hd & 3) * 128;
    f32x16 y[2];
#pragma unroll
    for (int pt = 0; pt < 2; ++pt) {
#pragma unroll
      for (int r = 0; r < 16; ++r) y[pt][r] = 0.f;
    }
#pragma unroll
    for (int s2 = 0; s2 < 4; ++s2) {
      bf16x8 f00 = ld_frag(prevj + loff + (2 * s2) * 16), f01 = ld_frag(prevj + loff + (2 * s2 + 1) * 16);
      bf16x8 f10 = ld_frag(prevj + loff + 32 * 128 + (2 * s2) * 16), f11 = ld_frag(prevj + loff + 32 * 128 + (2 * s2 + 1) * 16);
      y[0] = mfma32(f00, cf[2 * s2], y[0]);
      y[1] = mfma32(f10, cf[2 * s2], y[1]);
      y[0] = mfma32(f01, cf[2 * s2 + 1], y[0]);
      y[1] = mfma32(f11, cf[2 * s2 + 1], y[1]);
    }
    const float csl = csj[l];
    const float el = __expf(csl);
#pragma unroll
    for (int pt = 0; pt < 2; ++pt)
#pragma unroll
      for (int r = 0; r < 16; ++r) y[pt][r] *= el;
#pragma unroll
    for (int st = 0; st < 4; ++st) {
      if (st < ntile) {
#pragma unroll
        for (int ks = 0; ks < 2; ++ks) {
          float m8[8];
          {
            const int sb0 = 4 * hh + st * 32 + ks * 16;
            const f32x4 ca = *(const f32x4*)(csj + sb0), cb2 = *(const f32x4*)(csj + sb0 + 8);
            const f32x4 da = *(const f32x4*)(dtj + sb0), db2 = *(const f32x4*)(dtj + sb0 + 8);
#pragma unroll
            for (int jj = 0; jj < 4; ++jj) {
              m8[jj] = gacc[st][ks * 8 + jj] * __expf(csl - ca[jj]) * da[jj];
              m8[4 + jj] = gacc[st][ks * 8 + 4 + jj] * __expf(csl - cb2[jj]) * db2[jj];
            }
            if (st == ntile - 1) {
#pragma unroll
              for (int jj = 0; jj < 8; ++jj) {
                const int sloc = ks * 16 + 8 * (jj >> 2) + (jj & 3) + 4 * hh;
                m8[jj] = (sloc <= r31) ? m8[jj] : 0.f;
              }
            }
          }
          bf16x8 pf = as_bf16x8(pack8(m8));
#pragma unroll
          for (int pt = 0; pt < 2; ++pt) {
            const u16* xp = xTj + xoff + (pt * 32 * 128 + st * 32 + ks * 16);
            const U4 xv = *(const U4*)xp;
            y[pt] = mfma32(as_bf16x8(xv), pf, y[pt]);
          }
        }
      }
    }
    const float dsk = p.d_skip[layer * 16 + hd];
    const u16* xh = xrow + hd * 64 + hh * 16;
    const u16* zh = p.proj + paddr(R0 + l, CZ + hd * 64) + hh * 16;
    U4* ypj = ypk + (hd & 1) * 4 * 256;
#pragma unroll
    for (int pt = 0; pt < 2; ++pt) {
      float x16[16], z16[16], v16[16];
      unpack8(*(const U4*)(xh + pt * 32), x16); unpack8(*(const U4*)(xh + pt * 32 + 8), x16 + 8);
      unpack8(*(const U4*)(zh + pt * 32), z16); unpack8(*(const U4*)(zh + pt * 32 + 8), z16 + 8);
#pragma unroll
      for (int r = 0; r < 16; ++r) {
        v16[r] = (y[pt][r] + dsk * x16[r]) * silu_f(z16[r]);
        ssq += v16[r] * v16[r];
      }
      ypj[(pt * 2 + 0) * 256] = pack8(v16);
      ypj[(pt * 2 + 1) * 256] = pack8(v16 + 8);
    }
  }
  ssq += __shfl_xor(ssq, 32, 64);
  if (hh == 0) ssq_s[w * 32 + r31] = ssq;
  __syncthreads();
  ssq = ssq_s[w * 32 + r31] + ssq_s[(w ^ 1) * 32 + r31];
  const float rstd = rsqrtf(ssq * (1.f / 256.f) + EPS);
#pragma unroll 1
  for (int j = 0; j < 2; ++j) {
    int hd = g * 4 + hp * 2 + j;
    asm volatile("" : "+s"(hd));
    const float* nwp = p.ssm_norm + layer * 1024 + hd * 64 + hh * 16;
    u16* yh = yrow + hd * 64 + hh * 16;
    const U4* ypj = ypk + (hd & 1) * 4 * 256;
#pragma unroll
    for (int pt = 0; pt < 2; ++pt)
#pragma unroll
      for (int h2 = 0; h2 < 2; ++h2) {
        const f32x4 nw0 = *(const f32x4*)(nwp + pt * 32 + h2 * 8), nw1 = *(const f32x4*)(nwp + pt * 32 + h2 * 8 + 4);
        float v8[8];
        unpack8(ypj[(pt * 2 + h2) * 256], v8);
        v8[0] *= rstd * nw0.x; v8[1] *= rstd * nw0.y; v8[2] *= rstd * nw0.z; v8[3] *= rstd * nw0.w;
        v8[4] *= rstd * nw1.x; v8[5] *= rstd * nw1.y; v8[6] *= rstd * nw1.z; v8[7] *= rstd * nw1.w;
        *(U4*)(yh + pt * 32 + h2 * 8) = pack8(v8);
      }
  }
  __syncthreads();
}

__device__ __forceinline__ void attn_load(const Params& p, int it, int tid, U4 (&kreg)[8], U4 (&vreg)[8]) {
  const int blk = it & 31;
  int t2 = it >> 5;
  const int g = t2 % 3; t2 /= 3;
  const int kvh = t2 & 7, bl = t2 >> 3;
  const int dsh = 2 * g, d = 1 << dsh, nper = 32 >> dsh;
  const int r = blk / nper, n = blk % nper;
  const size_t Rb = (size_t)bl * S_;
#pragma unroll
  for (int i = 0; i < 8; ++i) {
    const int q = tid + 256 * i;
    const int row = q >> 3, chk = q & 7;
    const int ik = (n - 1) * 128 + row;
    const bool ok = ik >= 0;
    const size_t krow = Rb + (size_t)(ok ? ik : 0) * d + r;
    U4 kv = *(const U4*)(p.proj + paddr(krow, CK + kvh * 64 + chk * 8));
    U4 vv = *(const U4*)(p.proj + paddr(krow, CV + kvh * 64 + chk * 8));
    kreg[i] = ok ? kv : U4{0u, 0u, 0u, 0u};
    vreg[i] = ok ? vv : U4{0u, 0u, 0u, 0u};
  }
}

__device__ void attn_item(const Params& p, int it, int it_next, U4 (&kreg)[8], U4 (&vreg)[8], char* smem) {
  const int tid = otid(), lane = tid & 63, w = tid >> 6;
  const int blk = it & 31;
  int t2 = it >> 5;
  const int g = t2 % 3; t2 /= 3;
  const int kvh = t2 & 7, bl = t2 >> 3;
  const int dsh = 2 * g;
  const int d = 1 << dsh;
  const int nper = 32 >> dsh;
  const int r = blk / nper, n = blk % nper;
  u16* Ks = (u16*)smem;
  u16* Vs = Ks + 256 * 72;
  const size_t Rb = (size_t)bl * S_;
#pragma unroll
  for (int i = 0; i < 8; ++i) {
    int q = tid + 256 * i;
    int row = q >> 3, chk = q & 7;
    *(U4*)(Ks + row * 72 + chk * 8) = kreg[i];
    *(U4*)(Vs + row * 72 + chk * 8) = vreg[i];
  }
  const int r31 = lane & 31, hh = lane >> 5;
  const int iq = 32 * w + r31;
  const size_t rq_row = Rb + (size_t)(n * 128 + iq) * d + r;
  bf16x8 qf[4];
  {
    const u16* qp = p.proj + paddr(rq_row, CQ + g * 512 + kvh * 64) + hh * 8;
#pragma unroll
    for (int s = 0; s < 4; ++s) qf[s] = ld_frag(qp + s * 16);
  }
  __syncthreads();
  if (it_next >= 0) attn_load(p, it_next, tid, kreg, vreg);
  f32x16 sacc[5];
#pragma unroll
  for (int kt = 0; kt < 5; ++kt) {
#pragma unroll
    for (int rr = 0; rr < 16; ++rr) sacc[kt][rr] = 0.f;
    const u16* kp = Ks + (32 * (w + kt) + r31) * 72 + hh * 8;
#pragma unroll
    for (int s = 0; s < 4; ++s) sacc[kt] = mfma32(ld_frag(kp + s * 16), qf[s], sacc[kt]);
  }
  {
    const int tq = r31 - 4 * hh;
#pragma unroll
    for (int rr = 0; rr < 16; ++rr) {
      const int c = (rr & 3) + 8 * (rr >> 2);
      if (c < tq) sacc[0][rr] = -INFINITY;
      if (c > tq) sacc[4][rr] = -INFINITY;
    }
    if (n == 0) {
#pragma unroll
      for (int kt = 0; kt < 5; ++kt)
#pragma unroll
        for (int rr = 0; rr < 16; ++rr) {
          const int kk = 32 * (w + kt) + (rr & 3) + 8 * (rr >> 2) + 4 * hh;
          if (kk < 128) sacc[kt][rr] = -INFINITY;
        }
    }
  }
  float mx = -INFINITY;
#pragma unroll
  for (int kt = 0; kt < 5; ++kt)
#pragma unroll
    for (int rr = 0; rr < 16; ++rr) mx = fmaxf(mx, sacc[kt][rr]);
  mx = fmaxf(mx, __shfl_xor(mx, 32, 64));
  const float c2 = 0.125f * 1.4426950408889634f;
  const float mb = mx * c2;
  float den = 0.f;
#pragma unroll
  for (int kt = 0; kt < 5; ++kt)
#pragma unroll
    for (int rr = 0; rr < 16; ++rr) {
      float e = __builtin_amdgcn_exp2f(__builtin_fmaf(sacc[kt][rr], c2, -mb));
      sacc[kt][rr] = e;
      den += e;
    }
  den += __shfl_xor(den, 32, 64);
  f32x16 o[2];
#pragma unroll
  for (int et = 0; et < 2; ++et)
#pragma unroll
    for (int rr = 0; rr < 16; ++rr) o[et][rr] = 0.f;
#pragma unroll
  for (int kt = 0; kt < 5; ++kt)
#pragma unroll
    for (int ks = 0; ks < 2; ++ks) {
      float p8[8];
#pragma unroll
      for (int jj = 0; jj < 8; ++jj) p8[jj] = sacc[kt][ks * 8 + jj];
      bf16x8 pf = as_bf16x8(pack8(p8));
#pragma unroll
      for (int et = 0; et < 2; ++et) {
        const int trq = (lane & 15) >> 2, trp = lane & 3, trg = (lane >> 4) & 1;
        const u16* vp = Vs + (32 * (w + kt) + 16 * ks + 4 * hh + trq) * 72 + et * 32 + 16 * (trp & 1) + 8 * trg + 4 * (trp >> 1);
        typedef short v4s_t __attribute__((ext_vector_type(4)));
        v4s_t v0 = __builtin_amdgcn_ds_read_tr16_b64_v4i16((LAS v4s_t*)vp);
        v4s_t v1 = __builtin_amdgcn_ds_read_tr16_b64_v4i16((LAS v4s_t*)(vp + 8 * 72));
        bf16x8 vfr;
        vfr[0] = v0[0]; vfr[1] = v0[1]; vfr[2] = v0[2]; vfr[3] = v0[3];
        vfr[4] = v1[0]; vfr[5] = v1[1]; vfr[6] = v1[2]; vfr[7] = v1[3];
        o[et] = mfma32(vfr, pf, o[et]);
      }
    }
  const float inv = __builtin_amdgcn_rcpf(den);
  const size_t rloc = rq_row;
  u16* op = p.og + ((size_t)g * TC + rloc) * 512 + kvh * 64;
#pragma unroll
  for (int et = 0; et < 2; ++et)
#pragma unroll
    for (int h2 = 0; h2 < 2; ++h2) {
      U4 ov;
      ov.x = pack2(o[et][h2 * 8 + 0] * inv, o[et][h2 * 8 + 1] * inv);
      ov.y = pack2(o[et][h2 * 8 + 2] * inv, o[et][h2 * 8 + 3] * inv);
      ov.z = pack2(o[et][h2 * 8 + 4] * inv, o[et][h2 * 8 + 5] * inv);
      ov.w = pack2(o[et][h2 * 8 + 6] * inv, o[et][h2 * 8 + 7] * inv);
      *(U4*)(op + et * 32 + hh * 16 + h2 * 8) = ov;
    }
  if (hh == 0) p.lse[((size_t)g * TC + rloc) * 8 + kvh] = mx * 0.125f + __logf(den);
  __syncthreads();
}

__device__ void attn_combine_item(const Params& p, int it) {
  const int t512 = otid512();
  const int chk = t512 & 63, kvh = chk >> 3;
  float l0[4], l1[4], l2[4];
  U4 ra[4], rb[4], rc[4], rg[4];
#pragma unroll
  for (int i = 0; i < 4; ++i) {
    const size_t row = (size_t)((it * 4 + i) * 512 + t512) >> 6;
    l0[i] = p.lse[((size_t)0 * TC + row) * 8 + kvh];
    l1[i] = p.lse[((size_t)1 * TC + row) * 8 + kvh];
    l2[i] = p.lse[((size_t)2 * TC + row) * 8 + kvh];
    ra[i] = *(const U4*)(p.og + ((size_t)0 * TC + row) * 512 + chk * 8);
    rb[i] = *(const U4*)(p.og + ((size_t)1 * TC + row) * 512 + chk * 8);
    rc[i] = *(const U4*)(p.og + ((size_t)2 * TC + row) * 512 + chk * 8);
    rg[i] = *(const U4*)(p.proj + paddr(row, CGA + chk * 8));
  }
#pragma unroll
  for (int i = 0; i < 4; ++i) {
    const size_t row = (size_t)((it * 4 + i) * 512 + t512) >> 6;
    float m = fmaxf(l0[i], fmaxf(l1[i], l2[i]));
    float e0 = __expf(l0[i] - m), e1 = __expf(l1[i] - m), e2 = __expf(l2[i] - m);
    float inv = __builtin_amdgcn_rcpf(e0 + e1 + e2);
    e0 *= inv; e1 *= inv; e2 *= inv;
    float a[8], b[8], c[8], gt[8], o[8];
    unpack8(ra[i], a); unpack8(rb[i], b); unpack8(rc[i], c); unpack8(rg[i], gt);
#pragma unroll
    for (int e = 0; e < 8; ++e) o[e] = (e0 * a[e] + e1 * b[e] + e2 * c[e]) * silu_f(gt[e]);
    *(U4*)(p.yattn + row * 512 + chk * 8) = pack8(o);
  }
}

__device__ void shortconv_item(const Params& p, int layer, int it) {
  const float* cw = p.sc_conv_w + (size_t)layer * 3 * 512;
  const int t512 = otid512();
  const int chk = t512 & 63;
  f32x4 w0[3], w1[3];
#pragma unroll
  for (int k = 0; k < 3; ++k) { w0[k] = *(const f32x4*)(cw + k * 512 + chk * 8); w1[k] = *(const f32x4*)(cw + k * 512 + chk * 8 + 4); }
#pragma unroll
  for (int ip = 0; ip < 2; ++ip) {
    U4 ru[2][3], rc[2][3], rb[2], rgs[2];
#pragma unroll
    for (int j = 0; j < 2; ++j) {
      const size_t row = (size_t)((it * 4 + ip * 2 + j) * 512 + t512) >> 6;
      const int tin = (int)(row & (S_ - 1));
#pragma unroll
      for (int k = 0; k < 3; ++k) {
        const bool ok = tin - 2 + k >= 0;
        const size_t rr = ok ? row - 2 + k : row;
        U4 u = *(const U4*)(p.proj + paddr(rr, CU + chk * 8));
        U4 c = *(const U4*)(p.proj + paddr(rr, CCS + chk * 8));
        ru[j][k] = ok ? u : U4{0u, 0u, 0u, 0u};
        rc[j][k] = ok ? c : U4{0u, 0u, 0u, 0u};
      }
      rb[j] = *(const U4*)(p.proj + paddr(row, CBS + chk * 8));
      rgs[j] = *(const U4*)(p.proj + paddr(row, CGS + chk * 8));
    }
#pragma unroll
    for (int j = 0; j < 2; ++j) {
      const size_t row = (size_t)((it * 4 + ip * 2 + j) * 512 + t512) >> 6;
      float acc[8];
#pragma unroll
      for (int e = 0; e < 8; ++e) acc[e] = 0.f;
#pragma unroll
      for (int k = 0; k < 3; ++k) {
        float u8[8], c8[8];
        unpack8(ru[j][k], u8); unpack8(rc[j][k], c8);
        acc[0] += w0[k].x * (c8[0] * u8[0]); acc[1] += w0[k].y * (c8[1] * u8[1]);
        acc[2] += w0[k].z * (c8[2] * u8[2]); acc[3] += w0[k].w * (c8[3] * u8[3]);
        acc[4] += w1[k].x * (c8[4] * u8[4]); acc[5] += w1[k].y * (c8[5] * u8[5]);
        acc[6] += w1[k].z * (c8[6] * u8[6]); acc[7] += w1[k].w * (c8[7] * u8[7]);
      }
      float b8[8], g8[8], o[8];
      unpack8(rb[j], b8); unpack8(rgs[j], g8);
#pragma unroll
      for (int e = 0; e < 8; ++e) o[e] = b8[e] * acc[e] * silu_f(g8[e]);
      *(U4*)(p.ysc + row * 512 + chk * 8) = pack8(o);
    }
  }
}

struct ScanSt { u32 lv[32]; float dv[32]; };
struct CombSt { float l0[4], l1[4], l2[4]; U4 ra[4], rb[4], rc[4], rg[4]; };
struct ResSt { f32x4 o[4], xv[4], wv[4]; };
__device__ __forceinline__ void scan_load(const Params& p, int it, int t512, ScanSt& st) {
  const int q = it * 512 + t512;
  const int e2 = q & 4095, bh = q >> 12, bl = bh >> 4, hd = bh & 15;
#pragma unroll
  for (int c = 0; c < 32; ++c) {
    const size_t sidx = ((size_t)bl * 32 + c) * 16 + hd;
    st.lv[c] = *(const u32*)(p.stloc + sidx * 8192 + e2 * 2);
    st.dv[c] = p.dec[sidx];
  }
}
__device__ __forceinline__ void scan_fin(const Params& p, int it, int t512, const ScanSt& st) {
  const int q = it * 512 + t512;
  const int e2 = q & 4095, bh = q >> 12, bl = bh >> 4, hd = bh & 15;
  float s0 = 0.f, s1 = 0.f;
#pragma unroll
  for (int c = 0; c < 32; ++c) {
    const size_t sidx = ((size_t)bl * 32 + c) * 16 + hd;
    *(u32*)(p.prev + sidx * 8192 + e2 * 2) = pack2(s0, s1);
    s0 = s0 * st.dv[c] + lo2f(st.lv[c]);
    s1 = s1 * st.dv[c] + hi2f(st.lv[c]);
  }
}
__device__ __forceinline__ void comb_load(const Params& p, int it, int t512, CombSt& st) {
  const int chk = t512 & 63, kvh = chk >> 3;
#pragma unroll
  for (int i = 0; i < 4; ++i) {
    const size_t row = (size_t)((it * 4 + i) * 512 + t512) >> 6;
    st.l0[i] = p.lse[((size_t)0 * TC + row) * 8 + kvh];
    st.l1[i] = p.lse[((size_t)1 * TC + row) * 8 + kvh];
    st.l2[i] = p.lse[((size_t)2 * TC + row) * 8 + kvh];
    st.ra[i] = *(const U4*)(p.og + ((size_t)0 * TC + row) * 512 + chk * 8);
    st.rb[i] = *(const U4*)(p.og + ((size_t)1 * TC + row) * 512 + chk * 8);
    st.rc[i] = *(const U4*)(p.og + ((size_t)2 * TC + row) * 512 + chk * 8);
    st.rg[i] = *(const U4*)(p.proj + paddr(row, CGA + chk * 8));
  }
}
__device__ __forceinline__ void comb_fin(const Params& p, int it, int t512, const CombSt& st) {
  const int chk = t512 & 63;
#pragma unroll
  for (int i = 0; i < 4; ++i) {
    const size_t row = (size_t)((it * 4 + i) * 512 + t512) >> 6;
    float m = fmaxf(st.l0[i], fmaxf(st.l1[i], st.l2[i]));
    float e0 = __expf(st.l0[i] - m), e1 = __expf(st.l1[i] - m), e2 = __expf(st.l2[i] - m);
    float inv = __builtin_amdgcn_rcpf(e0 + e1 + e2);
    e0 *= inv; e1 *= inv; e2 *= inv;
    float a[8], b[8], c[8], gt[8], o[8];
    unpack8(st.ra[i], a); unpack8(st.rb[i], b); unpack8(st.rc[i], c); unpack8(st.rg[i], gt);
#pragma unroll
    for (int e = 0; e < 8; ++e) o[e] = (e0 * a[e] + e1 * b[e] + e2 * c[e]) * silu_f(gt[e]);
    *(U4*)(p.yattn + row * 512 + chk * 8) = pack8(o);
  }
}
__device__ __forceinline__ void res_load(const Params& p, int layer, int ch, int it, int t512, ResSt& st) {
  const int lane = t512 & 63, w = t512 >> 6;
  const int rl = it * 8 + w;
  const size_t rg = (size_t)ch * TC + rl;
  const float* xs = (layer == 0 ? p.x : p.out) + rg * D_;
  const float* wp = p.norm_post + layer * D_;
#pragma unroll
  for (int i = 0; i < 4; ++i) {
    int c = (i * 64 + lane) * 4;
    U2 pa = *(const U2*)(p.outA + (size_t)rl * D_ + c);
    st.xv[i] = *(const f32x4*)(xs + c);
    st.wv[i] = *(const f32x4*)(wp + c);
    st.o[i].x = lo2f(pa.x); st.o[i].y = hi2f(pa.x); st.o[i].z = lo2f(pa.y); st.o[i].w = hi2f(pa.y);
  }
}
__device__ __forceinline__ void res_fin(const Params& p, int layer, int ch, int it, int t512, const ResSt& st) {
  const int lane = t512 & 63, w = t512 >> 6;
  const int rl = it * 8 + w;
  const size_t rg = (size_t)ch * TC + rl;
  float* xd = p.out + rg * D_;
  float ps = 0.f;
#pragma unroll
  for (int i = 0; i < 4; ++i) ps += st.o[i].x * st.o[i].x + st.o[i].y * st.o[i].y + st.o[i].z * st.o[i].z + st.o[i].w * st.o[i].w;
  ps = wave_sum(ps);
  const float rstd = rsqrtf(ps * (1.f / D_) + EPS);
  f32x4 v[4];
  float ss = 0.f;
#pragma unroll
  for (int i = 0; i < 4; ++i) {
    int c = (i * 64 + lane) * 4;
    v[i] = st.xv[i] + st.o[i] * rstd * st.wv[i];
    *(f32x4*)(xd + c) = v[i];
    ss += v[i].x * v[i].x + v[i].y * v[i].y + v[i].z * v[i].z + v[i].w * v[i].w;
  }
  if (layer == 0) {
    ss = wave_sum(ss);
    float r2 = rsqrtf(ss * (1.f / D_) + EPS);
#pragma unroll
    for (int i = 0; i < 4; ++i) {
      U2 ov;
      ov.x = pack2(v[i].x * r2, v[i].y * r2);
      ov.y = pack2(v[i].z * r2, v[i].w * r2);
      *(U2*)(p.h + rg * D_ + (i * 64 + lane) * 4) = ov;
    }
  }
}

__device__ __forceinline__ void do_phase(const Params& p, int ph, int layer, int ch, char* smem0, int dup = 0) {
  const int G = gridDim.x, b0 = blockIdx.x;
  const int half_ = __builtin_amdgcn_readfirstlane(otid512() >> 8);
  char* smem = smem0 + half_ * HSMEM;
  if (ph == 0) {
    phase_weights(p, smem0);
  } else if (ph == 1) {
    pg8::Sched S; pg8::Epi E;
    E.O16 = p.proj; E.ld16 = NP; E.T16 = p.proj; E.ldt = NP; E.gate = p.proj; E.ldg = NP;
    S.kind = 0; S.so.init(TC, NP, G, b0); S.n = 0; S.mode0 = 0;
    S.gA = (const char*)(p.h + (size_t)ch * TC * D_); S.gB = (const char*)(p.WinT + (size_t)layer * NP * D_);
    S.tstep = (size_t)256 * D_ * 2;
    S.u0.pm = 0; S.u0.pn = 0; S.u0.a = S.gA; S.u0.b = S.gB; S.u0.mode = 0; S.u0.gcol = 0; S.u1 = S.u0;
    __syncthreads();
    pg8::gemm_phase((LAS unsigned char*)smem0, D_, S, E);
    {
      const int idx = layer * NCH + ch;
      constexpr int NWG = (TC / 256) * (NP / 256);
      const int nlong = NWG % G;
      if (idx > 0 && b0 >= nlong) {
        const int pl = (idx - 1) / NCH, pc = (idx - 1) % NCH;
        for (int it = b0 - nlong; it < NR1; it += G - nlong) resid_item(p, pl, pc, it);
      }
    }
  } else if (ph == 2) {
    constexpr int NA = NB * 32 * 4 * 2 / 2, NATT = NB * 8 * 3 * 32 / 2, NSC = TC * 64 / 2048;
    for (int sl = b0; sl < NA; sl += G) ssd_passA(p, layer, 2 * sl + half_, smem);
    {
      U4 kreg[8], vreg[8];
      int sl = (b0 + G - (NA % G)) % G;
      if (sl < NATT) attn_load(p, 2 * sl + half_, otid(), kreg, vreg);
      for (; sl < NATT; sl += G) {
        const int nx = sl + G;
        attn_item(p, 2 * sl + half_, nx < NATT ? 2 * nx + half_ : -1, kreg, vreg, smem);
      }
    }
    for (int it = (b0 + G - ((NA + NATT) % G)) % G; it < NSC; it += G) shortconv_item(p, layer, it);
  } else if (ph == 3) {
    constexpr int NS = NB * 16 * 4096 / 512, NCMB = TC * 64 / 2048;
    const int idx = layer * NCH + ch;
    const int pl = idx > 0 ? (idx - 1) / NCH : 0, pc = idx > 0 ? (idx - 1) % NCH : 0;
    const int t512 = otid512();
    for (int k = b0; k < NS || k < NCMB || (idx > 0 && NR1 + k < TC / 8); k += G) {
      const bool hs = k < NS, hc = k < NCMB, hr = idx > 0 && (NR1 + k) < TC / 8;
      ScanSt ss; CombSt cs; ResSt rs;
      if (hs) scan_load(p, k, t512, ss);
      if (hc) comb_load(p, k, t512, cs);
      if (hr) res_load(p, pl, pc, NR1 + k, t512, rs);
      if (hs) scan_fin(p, k, t512, ss);
      if (hc) comb_fin(p, k, t512, cs);
      if (hr) res_fin(p, pl, pc, NR1 + k, t512, rs);
    }
  } else if (ph == 4) {
    for (int sl = b0; sl < NB * 32 * 4 * 2 / 2; sl += G) ssd_passC(p, layer, 2 * sl + half_, smem);
  } else if (ph == 5) {
    for (int it = b0; it < (TC / 256) * 8; it += G) merge_tile8(p, layer, it, smem0);
  } else if (ph == 6) {
    for (int it = b0; it < (TC / 256) * 8; it += G) wout_tile8(p, layer, it, smem0);
  } else {
    for (int it = b0; it < TC / 8; it += G) resid_item(p, 1, NCH - 1, it);
  }
}

#define XB_TMO      128
#define XB_XCNT(j)  (256  + 64 * (j))
#define XB_XSUB(j)  (1280 + 64 * (j))
#define XB_XGEN(j)  (2304 + 64 * (j))
#define XB_TOP      3328
#define XB_TOPGEN   3392
#define XCD_BAR_WORDS 3456
#define XB_SPIN_CAP (1u << 20)
__device__ __forceinline__ unsigned xb_ld(unsigned* p) { return __hip_atomic_load(p, __ATOMIC_RELAXED, __HIP_MEMORY_SCOPE_AGENT); }
__device__ __forceinline__ unsigned xb_add(unsigned* p, unsigned v) { return __hip_atomic_fetch_add(p, v, __ATOMIC_RELAXED, __HIP_MEMORY_SCOPE_AGENT); }
__device__ __forceinline__ unsigned xb_xcc_id() { return (unsigned)__builtin_amdgcn_s_getreg((3 << 11) | 20) & 0xFu; }
#define XB_SPIN(cond, bar) do { unsigned _sp = 0; while (cond) { __builtin_amdgcn_s_sleep(1); \
    if ((++_sp & 255u) == 0u) { if (xb_ld(&(bar)[XB_TMO])) break; if (_sp > XB_SPIN_CAP) { atomicAdd(&(bar)[XB_TMO], 1u); break; } } } } while (0)
struct XcdBarrier { unsigned* bar; unsigned x; volatile LAS unsigned* st; };
__device__ __forceinline__ XcdBarrier xcd_barrier_post(unsigned* bar, volatile LAS unsigned* st) {
  XcdBarrier b; b.bar = bar; b.x = xb_xcc_id(); b.st = st;
  if (threadIdx.x == 0) (void)xb_add(&bar[XB_XCNT(b.x)], 1u);
  return b;
}
__device__ __forceinline__ void xcd_barrier_complete(unsigned* bar, unsigned x, unsigned& nloc, unsigned& nx) {
  const unsigned G = gridDim.x * gridDim.y * gridDim.z;
  unsigned sum, cnt, mine, sp = 0u;
  for (;;) {
    sum = 0u; cnt = 0u; mine = 0u;
#pragma unroll
    for (unsigned j = 0; j < 16; ++j) { const unsigned c = xb_ld(&bar[XB_XCNT(j)]); sum += c; cnt += (c > 0u) ? 1u : 0u; mine = (j == x) ? c : mine; }
    if (sum == G) break;
    __builtin_amdgcn_s_sleep(1);
    if ((++sp & 255u) == 0u) { if (xb_ld(&bar[XB_TMO])) break; if (sp > XB_SPIN_CAP) { atomicAdd(&bar[XB_TMO], 1u); break; } }
  }
  nloc = mine > 0u ? mine : 1u; nx = cnt > 0u ? cnt : 1u;
}
__device__ __forceinline__ void xcd_barrier(const XcdBarrier& b) {
  asm volatile("s_waitcnt vmcnt(0)" ::: "memory");
  __syncthreads();
  if (threadIdx.x == 0) {
    unsigned* bar = b.bar;
    __builtin_amdgcn_s_waitcnt(0);
    unsigned nloc = b.st[0], nx = b.st[1];
    if (nloc == 0u) { xcd_barrier_complete(bar, b.x, nloc, nx); b.st[0] = nloc; b.st[1] = nx; }
    const unsigned old = xb_add(&bar[XB_XSUB(b.x)], 1u);
    const unsigned gen = old / nloc;
    if (old + 1u == (gen + 1u) * nloc) {
      __builtin_amdgcn_fence(__ATOMIC_RELEASE, "agent");
      asm volatile("s_waitcnt vmcnt(0)" ::: "memory");
      const unsigned og = xb_add(&bar[XB_TOP], 1u);
      const unsigned tg = og / nx;
      if (og + 1u == (tg + 1u) * nx) xb_add(&bar[XB_TOPGEN], 1u);
      else XB_SPIN(xb_ld(&bar[XB_TOPGEN]) == tg, bar);
      __builtin_amdgcn_fence(__ATOMIC_ACQUIRE, "agent");
      xb_add(&bar[XB_XGEN(b.x)], 1u);
      asm volatile("s_waitcnt vmcnt(0)" ::: "memory");
    } else {
      XB_SPIN(xb_ld(&bar[XB_XGEN(b.x)]) == gen, bar);
      __builtin_amdgcn_fence(__ATOMIC_ACQUIRE, "agent");
      asm volatile("s_waitcnt vmcnt(0)" ::: "memory");
    }
  }
  __syncthreads();
}

#if COOP
__global__ void __launch_bounds__(512, 2) mega_kernel(Params p) {
  extern __shared__ __attribute__((aligned(16))) char smem[];
  cg::grid_group grid = cg::this_grid();
#ifdef ONLY_PH
  do_phase(p, ONLY_PH, 0, 1, smem); return;
#endif
  constexpr int NSTEP = 2 + 2 * NCH * 6;
  volatile LAS unsigned* st = (volatile LAS unsigned*)(LAS unsigned char*)(smem + SMEM_BYTES);
  if (threadIdx.x < 4) st[threadIdx.x] = 0u;
  if (blockIdx.x == 0) for (int i = threadIdx.x; i < XCD_BAR_WORDS; i += 512) p.bar[i] = 0u;
  __syncthreads();
  XcdBarrier xb;
#pragma unroll 1
  for (int step = 0; step < NSTEP; ++step) {
    int ph, layer, ch;
    if (step == 0) { ph = 0; layer = 0; ch = 0; }
    else if (step == NSTEP - 1) { ph = 7; layer = 1; ch = NCH - 1; }
    else {
      int s1 = step - 1;
      ph = 1 + s1 % 6;
      int it = s1 / 6;
      layer = it / NCH; ch = it % NCH;
    }
    do_phase(p, ph, layer, ch, smem);
#ifdef DUP_PH
    if (ph == DUP_PH) { xcd_barrier(xb); do_phase(p, ph, layer, ch, smem, 1); }
#endif
    if (step == 0) {
      grid.sync();
      xb = xcd_barrier_post(p.bar, st);
    } else if (step != NSTEP - 1) {
      xcd_barrier(xb);
    }
  }
}
#else
__global__ void __launch_bounds__(512, 2) phase_kernel(Params p, int ph, int layer, int ch) {
  extern __shared__ __attribute__((aligned(16))) char smem[];
  do_phase(p, ph, layer, ch, smem);
}
#endif

extern "C" void kernel_launch(void* const* d_in, const int* in_sizes, int n_in, void* d_out, int out_size, void* d_ws,
                              size_t ws_size, hipStream_t stream) {
  Params p{};
  p.x = (const float*)d_in[0]; p.norm_pre = (const float*)d_in[1]; p.norm_post = (const float*)d_in[2];
  p.w_in = (const float*)d_in[3]; p.ssm_conv_w = (const float*)d_in[4]; p.ssm_conv_b = (const float*)d_in[5];
  p.dt_bias = (const float*)d_in[6]; p.a_log = (const float*)d_in[7]; p.d_skip = (const float*)d_in[8];
  p.ssm_norm = (const float*)d_in[9]; p.sc_conv_w = (const float*)d_in[10]; p.p_ssm = (const float*)d_in[11];
  p.p_attn = (const float*)d_in[12]; p.p_sc = (const float*)d_in[13]; p.w_out = (const float*)d_in[14];
  p.out = (float*)d_out;
  char* ws = (char*)d_ws;
  size_t off = 0;
  auto take = [&](size_t bytes) { char* r = ws + off; off += (bytes + 255) & ~(size_t)255; return r; };
  p.WinT = (u16*)take((size_t)2 * NP * D_ * 2);
  p.PsT = (u16*)take((size_t)2 * 1024 * 1024 * 2);
  p.PaT = (u16*)take((size_t)2 * 1024 * 512 * 2);
  p.PcT = (u16*)take((size_t)2 * 1024 * 512 * 2);
  p.WoT = (u16*)take((size_t)2 * 1024 * 1024 * 2);
  p.h = (u16*)take((size_t)T_ * D_ * 2);
  p.proj = (u16*)take((size_t)TC * NP * 2);
  p.xc = (u16*)take((size_t)TC * 2048 * 2);
  p.xT = (u16*)take((size_t)NB * 32 * 16 * 8192 * 2);
  p.prev = (u16*)take((size_t)NB * 32 * 16 * 8192 * 2);
  p.og = (u16*)take((size_t)3 * TC * 512 * 2);
  p.yattn = (u16*)take((size_t)TC * 512 * 2);
  p.ysc = (u16*)take((size_t)TC * 512 * 2);
  p.yssm = (u16*)take((size_t)TC * 1024 * 2);
  p.Pa = (u16*)take((size_t)TC * 1024 * 2);
  p.Pb = p.og;
  p.stloc = (u16*)take((size_t)NB * 32 * 16 * 8192 * 2);
  p.outA = (u16*)take((size_t)TC * 1024 * 2);
  p.outB = p.xc;
  p.dec = (float*)take((size_t)NB * 32 * 16 * 4);
  p.lse = (float*)take((size_t)3 * TC * 8 * 4);
  p.bar = (unsigned*)take((size_t)XCD_BAR_WORDS * 4);
  if (off > ws_size) fprintf(stderr, "workspace too small: need %zu have %zu\n", off, ws_size);
#if COOP
  static int grid_blocks = 0;
  if (!grid_blocks) {
    int dev = 0, cus = 0, per_cu = 0;
    hipGetDevice(&dev);
    hipDeviceGetAttribute(&cus, hipDeviceAttributeMultiprocessorCount, dev);
    hipFuncSetAttribute((const void*)mega_kernel, hipFuncAttributeMaxDynamicSharedMemorySize, SMEM_BYTES + 16);
    hipOccupancyMaxActiveBlocksPerMultiprocessor(&per_cu, mega_kernel, 512, SMEM_BYTES + 16);
    if (per_cu > 1) per_cu = 1;
    grid_blocks = cus * per_cu;
  }
  void* args[] = {&p};
  hipError_t e = hipLaunchCooperativeKernel((void*)mega_kernel, dim3(grid_blocks), dim3(512), args, SMEM_BYTES + 16, stream);
  if (e != hipSuccess) fprintf(stderr, "cooperative launch failed: %s (grid %d)\n", hipGetErrorString(e), grid_blocks);
#else
  const int grid = 256;
  hipFuncSetAttribute((const void*)phase_kernel, hipFuncAttributeMaxDynamicSharedMemorySize, SMEM_BYTES);
  phase_kernel<<<grid, 512, SMEM_BYTES, stream>>>(p, 0, 0, 0);
  for (int layer = 0; layer < 2; ++layer)
    for (int ch = 0; ch < NCH; ++ch)
      for (int ph = 1; ph <= 6; ++ph) phase_kernel<<<grid, 512, SMEM_BYTES, stream>>>(p, ph, layer, ch);
  phase_kernel<<<grid, 512, SMEM_BYTES, stream>>>(p, 7, 1, NCH - 1);
#endif
}
```

```cpp
#include <hip/hip_runtime.h>
#include <hip/hip_cooperative_groups.h>
#include <cstdio>
#include <cstdint>
namespace cg = cooperative_groups;

#ifndef COOP
#define COOP 1
#endif

typedef unsigned short u16;
typedef unsigned int u32;
using bf16x8 = __attribute__((ext_vector_type(8))) short;
using f32x4 = __attribute__((ext_vector_type(4))) float;
using f32x16 = __attribute__((ext_vector_type(16))) float;
using U4 = __attribute__((ext_vector_type(4))) unsigned int;
using U2 = __attribute__((ext_vector_type(2))) unsigned int;

constexpr int D_ = 1024, S_ = 4096, NBATCH = 8, T_ = NBATCH * S_;
constexpr int NB = 2, TC = NB * S_, NCH = NBATCH / NB;
constexpr int NP = 11520;
constexpr int NORIG = 11280;
constexpr int CZ = 0, CX = 1024, CQ = 3072, CK = 4608, CV = 5120, CGA = 5632, CU = 6144, CBS = 6656,
              CCS = 7168, CGS = 7680, CM = 8192, CDT = 11264;
constexpr int NR1 = 768;
constexpr int HSMEM = 73728;
constexpr int SMEM_BYTES = 2 * HSMEM;
constexpr float EPS = 1e-6f;
__host__ __device__ __forceinline__ size_t paddr(size_t row, int col) {
  return ((((row >> 8) * (size_t)(NP / 256) + (size_t)(col >> 8)) * 16 + ((row >> 4) & 15)) * 4 + (size_t)((col >> 6) & 3)) * 1024 +
         (row & 15) * 64 + (size_t)(col & 63);
}

struct Params {
  const float *x, *norm_pre, *norm_post, *w_in, *ssm_conv_w, *ssm_conv_b, *dt_bias, *a_log, *d_skip,
      *ssm_norm, *sc_conv_w, *p_ssm, *p_attn, *p_sc, *w_out;
  float* out;
  u16 *WinT, *PsT, *PaT, *PcT, *WoT;
  u16 *h, *proj, *xc, *xT, *prev, *og, *yattn, *ysc, *yssm, *Pa, *Pb;
  float *dec, *lse;
  u16 *stloc, *outA, *outB;
  unsigned* bar;
};

__device__ __forceinline__ u32 pack2(float a, float b);
__device__ __forceinline__ int otid512() { int t = threadIdx.x; asm volatile("" : "+v"(t)); return t; }
__device__ __forceinline__ int otid() { return otid512() & 255; }
__device__ __forceinline__ u32 cvt_pk_bf16(float lo, float hi) { return pack2(lo, hi); }
__device__ __forceinline__ u16 f2bf(float f) {
  u32 u = __float_as_uint(f);
  u += 0x7fffu + ((u >> 16) & 1u);
  return (u16)(u >> 16);
}
__device__ __forceinline__ float bf2f(u16 h) { return __uint_as_float(((u32)h) << 16); }
__device__ __forceinline__ u32 pack2(float a, float b);
typedef float f32x2_t __attribute__((ext_vector_type(2)));
typedef __bf16 bf16x2_t __attribute__((ext_vector_type(2)));
__device__ __forceinline__ u32 pack2(float a, float b) { f32x2_t v = {a, b}; return __builtin_bit_cast(u32, __builtin_convertvector(v, bf16x2_t)); }
__device__ __forceinline__ float lo2f(u32 v) { return __uint_as_float(v << 16); }
__device__ __forceinline__ float hi2f(u32 v) { return __uint_as_float(v & 0xffff0000u); }
__device__ __forceinline__ float silu_f(float x) { return x * __builtin_amdgcn_rcpf(1.f + __expf(-x)); }
__device__ __forceinline__ float sigmoid_f(float x) { return __builtin_amdgcn_rcpf(1.f + __expf(-x)); }
__device__ __forceinline__ float softplus_f(float x) { const float e = __expf(x); return x > 20.f ? x : (e < 1e-4f ? e : __logf(1.f + e)); }
__device__ __forceinline__ float wave_sum(float v) {
#pragma unroll
  for (int o = 32; o > 0; o >>= 1) v += __shfl_xor(v, o, 64);
  return v;
}
__device__ __forceinline__ void unpack8(U4 v, float* f) {
  f[0] = lo2f(v.x); f[1] = hi2f(v.x); f[2] = lo2f(v.y); f[3] = hi2f(v.y);
  f[4] = lo2f(v.z); f[5] = hi2f(v.z); f[6] = lo2f(v.w); f[7] = hi2f(v.w);
}
__device__ __forceinline__ U4 pack8(const float* f) {
  U4 v; v.x = pack2(f[0], f[1]); v.y = pack2(f[2], f[3]); v.z = pack2(f[4], f[5]); v.w = pack2(f[6], f[7]);
  return v;
}
__device__ __forceinline__ f32x16 mfma32(bf16x8 a, bf16x8 b, f32x16 c) {
  return __builtin_amdgcn_mfma_f32_32x32x16_bf16(a, b, c, 0, 0, 0);
}
__device__ __forceinline__ f32x4 mfma16(bf16x8 a, bf16x8 b, f32x4 c) {
  return __builtin_amdgcn_mfma_f32_16x16x32_bf16(a, b, c, 0, 0, 0);
}
__device__ __forceinline__ bf16x8 as_bf16x8(U4 v) {
  return __builtin_bit_cast(bf16x8, v);
}
__device__ __forceinline__ bf16x8 ld_frag(const u16* p) { return as_bf16x8(*(const U4*)p); }

__device__ void transpose_tile(const float* __restrict__ src, int ld_src, u16* __restrict__ dst, int K, int n0,
                               int k0, int mapmode, const float* __restrict__ scale, char* smem) {
  float* tile = (float*)smem;
  const int tid = otid();
  const int nl = tid & 63;
  int n = n0 + nl;
  int col;
  if (mapmode == 0) col = n;
  else {
    if (n < 3072) col = n;
    else if (n < CDT) col = n + 16;
    else if (n < CDT + 16) col = 3072 + (n - CDT);
    else col = -1;
  }
  float v[32];
#pragma unroll
  for (int i = 0; i < 32; ++i) {
    int kk = (tid >> 6) + 4 * i;
    v[i] = (col >= 0) ? src[(size_t)(k0 + kk) * ld_src + col] : 0.f;
  }
  if (scale) {
#pragma unroll
    for (int i = 0; i < 32; ++i) v[i] *= scale[k0 + (tid >> 6) + 4 * i];
  }
#pragma unroll
  for (int i = 0; i < 32; ++i) tile[((tid >> 6) + 4 * i) * 65 + nl] = v[i];
  __syncthreads();
  {
    int nn = tid >> 2, kq = (tid & 3) * 32;
    u16* d = dst + (size_t)(n0 + nn) * K + k0 + kq;
#pragma unroll
    for (int h = 0; h < 4; ++h) {
      float f[8];
#pragma unroll
      for (int e = 0; e < 8; ++e) f[e] = tile[(kq + h * 8 + e) * 65 + nn];
      *(U4*)(d + h * 8) = pack8(f);
    }
  }
  __syncthreads();
}

__device__ void phase_weights(const Params& p, char* smem) {
  constexpr int NT_IN = (NP / 64) * 8, NT_PS = 128, NT_PA = 64, NT_PC = 64, NT_WO = 128;
  constexpr int PER_LAYER = NT_IN + NT_PS + NT_PA + NT_PC + NT_WO;
  const int half_ = __builtin_amdgcn_readfirstlane(otid512() >> 8);
  smem += half_ * HSMEM;
  for (int slot = blockIdx.x; slot < PER_LAYER; slot += gridDim.x) {
    int it = 2 * slot + half_;
    int l = it / PER_LAYER, r = it % PER_LAYER;
    if (r < NT_IN) {
      int nt = r / 8, kt = r % 8;
      transpose_tile(p.w_in + (size_t)l * D_ * NORIG, NORIG, p.WinT + (size_t)l * NP * D_, D_, nt * 64, kt * 128, 1,
                     p.norm_pre + l * D_, smem);
    } else if ((r -= NT_IN) < NT_PS) {
      int nt = r / 8, kt = r % 8;
      transpose_tile(p.p_ssm + (size_t)l * 1024 * 1024, 1024, p.PsT + (size_t)l * 1024 * 1024, 1024, nt * 64,
                     kt * 128, 0, nullptr, smem);
    } else if ((r -= NT_PS) < NT_PA) {
      int nt = r / 4, kt = r % 4;
      transpose_tile(p.p_attn + (size_t)l * 512 * 1024, 1024, p.PaT + (size_t)l * 1024 * 512, 512, nt * 64, kt * 128,
                     0, nullptr, smem);
    } else if ((r -= NT_PA) < NT_PC) {
      int nt = r / 4, kt = r % 4;
      transpose_tile(p.p_sc + (size_t)l * 512 * 1024, 1024, p.PcT + (size_t)l * 1024 * 512, 512, nt * 64, kt * 128, 0,
                     nullptr, smem);
    } else {
      r -= NT_PC;
      int nt = r / 8, kt = r % 8;
      transpose_tile(p.w_out + (size_t)l * 1024 * 1024, 1024, p.WoT + (size_t)l * 1024 * 1024, 1024, nt * 64,
                     kt * 128, 0, nullptr, smem);
    }
  }
  const int t512 = otid512();
  const int lane = t512 & 63, w = t512 >> 6;
  for (int it = blockIdx.x; it < T_ / 16; it += gridDim.x) {
    const int row = it * 16 + w * 2;
    const f32x4* xr = (const f32x4*)(p.x + (size_t)row * D_);
    f32x4 v[2][4];
    float ss0 = 0.f, ss1 = 0.f;
#pragma unroll
    for (int i = 0; i < 4; ++i) { v[0][i] = xr[i * 64 + lane]; v[1][i] = xr[256 + i * 64 + lane]; }
#pragma unroll
    for (int i = 0; i < 4; ++i) {
      ss0 += v[0][i].x * v[0][i].x + v[0][i].y * v[0][i].y + v[0][i].z * v[0][i].z + v[0][i].w * v[0][i].w;
      ss1 += v[1][i].x * v[1][i].x + v[1][i].y * v[1][i].y + v[1][i].z * v[1][i].z + v[1][i].w * v[1][i].w;
    }
    ss0 = wave_sum(ss0); ss1 = wave_sum(ss1);
    const float r0 = rsqrtf(ss0 * (1.f / D_) + EPS), r1 = rsqrtf(ss1 * (1.f / D_) + EPS);
#pragma unroll
    for (int i = 0; i < 4; ++i) {
      U2 o;
      o.x = pack2(v[0][i].x * r0, v[0][i].y * r0); o.y = pack2(v[0][i].z * r0, v[0][i].w * r0);
      *(U2*)(p.h + (size_t)row * D_ + (i * 64 + lane) * 4) = o;
      o.x = pack2(v[1][i].x * r1, v[1][i].y * r1); o.y = pack2(v[1][i].z * r1, v[1][i].w * r1);
      *(U2*)(p.h + (size_t)(row + 1) * D_ + (i * 64 + lane) * 4) = o;
    }
  }
}

#define LAS __attribute__((address_space(3)))
__device__ __forceinline__ int g_lds_byte(int r, int c) { const int st = (r >> 4) * 2 + (c >> 5), rr = r & 15, cc = c & 31, ob = rr * 64 + cc * 2; return st * 1024 + (ob ^ (((ob >> 9) & 1) << 5)); }
__device__ __forceinline__ void g_stage_rc(int b, int& R, int& C) { const int st = b / 1024, sb = b % 1024, swz = sb ^ (((sb >> 9) & 1) << 5); R = (st >> 1) * 16 + swz / 64; C = (st & 1) * 32 + (swz % 64) / 2; }
__device__ __forceinline__ void gemm_tile(const u16* __restrict__ A, int lda, const u16* __restrict__ Bt, int ldb,
                                          int K, f32x4 (&acc)[4][4], char* smem) {
  const int tid = otid(), lane = tid & 63, w = __builtin_amdgcn_readfirstlane(tid >> 6), wr = w >> 1, wc = w & 1;
  LAS unsigned char* lds = (LAS unsigned char*)smem;
  unsigned voA[4], voB[4];
#pragma unroll
  for (int i = 0; i < 4; ++i) {
    int R, C;
    g_stage_rc(tid * 16 + i * 4096, R, C);
    voA[i] = (unsigned)(R * lda + C) * 2u;
    voB[i] = (unsigned)(R * ldb + C) * 2u;
  }
  const unsigned ldsw = (unsigned)w * 1024u;
  const int fr = lane & 15, fq = lane >> 4;
  const int aoff = g_lds_byte(wr * 64 + fr, fq * 8), boff = g_lds_byte(wc * 64 + fr, fq * 8);
  const int nk = K / 64;
#define G_STAGE(buf, k0) do { _Pragma("unroll") for (int _i = 0; _i < 4; ++_i) { \
    __builtin_amdgcn_global_load_lds((const unsigned*)((const char*)A + (size_t)(k0) * 2 + voA[_i]), (LAS unsigned*)(lds + (buf) * 16384 + ldsw + _i * 4096), 16, 0, 0); \
    __builtin_amdgcn_global_load_lds((const unsigned*)((const char*)Bt + (size_t)(k0) * 2 + voB[_i]), (LAS unsigned*)(lds + 32768 + (buf) * 16384 + ldsw + _i * 4096), 16, 0, 0); } } while (0)
  G_STAGE(0, 0);
  for (int kt = 0; kt < nk; ++kt) {
    const int buf = kt & 1;
    asm volatile("s_waitcnt vmcnt(0)" ::: "memory");
    __syncthreads();
    if (kt + 1 < nk) {
      if (buf) G_STAGE(0, (kt + 1) * 64); else G_STAGE(1, (kt + 1) * 64);
    }
    const LAS unsigned char* as = lds + buf * 16384 + aoff;
    const LAS unsigned char* bs = lds + 32768 + buf * 16384 + boff;
#pragma unroll
    for (int ks = 0; ks < 2; ++ks) {
      bf16x8 af[4], bf[4];
#pragma unroll
      for (int mt = 0; mt < 4; ++mt) af[mt] = *(const LAS bf16x8*)(as + mt * 2048 + ks * 1024);
#pragma unroll
      for (int nt = 0; nt < 4; ++nt) bf[nt] = *(const LAS bf16x8*)(bs + nt * 2048 + ks * 1024);
#pragma unroll
      for (int mt = 0; mt < 4; ++mt)
#pragma unroll
        for (int nt = 0; nt < 4; ++nt) acc[mt][nt] = mfma16(bf[nt], af[mt], acc[mt][nt]);
    }
  }
#undef G_STAGE
  __syncthreads();
}

__device__ __forceinline__ void gemm_tile8(const u16* __restrict__ A, int lda, const u16* __restrict__ Bt, int ldb,
                                           int K, f32x4 (&acc)[4][4], char* smem) {
  const int tid = otid512(), lane = tid & 63, w = __builtin_amdgcn_readfirstlane(tid >> 6), wr = w >> 1, wc = w & 1;
  LAS unsigned char* lds = (LAS unsigned char*)smem;
  unsigned voA[2], voB[2];
#pragma unroll
  for (int i = 0; i < 2; ++i) {
    const int b = tid * 16 + i * 8192;
    const int R = b >> 7, cl = (b >> 4) & 7, C = (cl ^ (R & 7)) * 8;
    const int Rb = (R & 64) + ((R >> 2) & 3) * 16 + ((R >> 4) & 3) * 4 + (R & 3);
    voA[i] = (unsigned)(R * lda + C) * 2u;
    voB[i] = (unsigned)(Rb * ldb + C) * 2u;
  }
  const size_t a1step = (size_t)128 * lda * 2;
  const unsigned ldsw = (unsigned)w * 1024u;
  const int fr = lane & 15, fq = lane >> 4;
  const int arow = (wr >> 1) * 16384 + ((wr & 1) * 64 + fr) * 128;
  const int brow = 32768 + (wc * 64 + fr) * 128;
  const int ck0 = ((fq ^ (fr & 7)) << 4), ck1 = (((4 + fq) ^ (fr & 7)) << 4);
  const int nk = K / 64;
#define G8_STAGE(sb, k0) do { _Pragma("unroll") for (int _i = 0; _i < 2; ++_i) { \
    __builtin_amdgcn_global_load_lds((const unsigned*)((const char*)A + (size_t)(k0) * 2 + voA[_i]), (LAS unsigned*)(lds + (sb) + ldsw + _i * 8192), 16, 0, 0); \
    __builtin_amdgcn_global_load_lds((const unsigned*)((const char*)A + a1step + (size_t)(k0) * 2 + voA[_i]), (LAS unsigned*)(lds + (sb) + 16384 + ldsw + _i * 8192), 16, 0, 0); \
    __builtin_amdgcn_global_load_lds((const unsigned*)((const char*)Bt + (size_t)(k0) * 2 + voB[_i]), (LAS unsigned*)(lds + (sb) + 32768 + ldsw + _i * 8192), 16, 0, 0); } } while (0)
#define G8_COMPUTE(sb) do { \
    const LAS unsigned char* as_ = lds + (sb) + arow; const LAS unsigned char* bs_ = lds + (sb) + brow; \
    _Pragma("unroll") for (int ks = 0; ks < 2; ++ks) { \
      const int ck = ks ? ck1 : ck0; \
      bf16x8 af[4], bf[4]; \
      _Pragma("unroll") for (int mt = 0; mt < 4; ++mt) af[mt] = *(const LAS bf16x8*)(as_ + mt * 2048 + ck); \
      _Pragma("unroll") for (int nt = 0; nt < 4; ++nt) bf[nt] = *(const LAS bf16x8*)(bs_ + nt * 2048 + ck); \
      _Pragma("unroll") for (int mt = 0; mt < 4; ++mt) _Pragma("unroll") for (int nt = 0; nt < 4; ++nt) acc[mt][nt] = mfma16(bf[nt], af[mt], acc[mt][nt]); } } while (0)
  G8_STAGE(0, 0); G8_STAGE(49152, 64);
  int cur = 0, nxt2 = 2 * 49152;
  for (int kt = 0; kt < nk - 1; ++kt) {
    asm volatile("s_waitcnt vmcnt(6)" ::: "memory");
    __builtin_amdgcn_s_barrier();
    asm volatile("" ::: "memory");
    if (kt + 2 < nk) G8_STAGE(nxt2, (kt + 2) * 64);
    G8_COMPUTE(cur);
    cur = (cur == 2 * 49152) ? 0 : cur + 49152;
    nxt2 = (nxt2 == 2 * 49152) ? 0 : nxt2 + 49152;
  }
  asm volatile("s_waitcnt vmcnt(0)" ::: "memory");
  __builtin_amdgcn_s_barrier();
  asm volatile("" ::: "memory");
  G8_COMPUTE(cur);
#undef G8_STAGE
#undef G8_COMPUTE
  __syncthreads();
}

__device__ __forceinline__ void zero_acc(f32x4 (&acc)[4][4]) {
#pragma unroll
  for (int a = 0; a < 4; ++a)
#pragma unroll
    for (int b = 0; b < 4; ++b) acc[a][b] = f32x4{0.f, 0.f, 0.f, 0.f};
}

namespace pg8 {
constexpr int BM = 256, BK = 64, HALF = 128, HTB = HALF * BK * 2, NXCD = 8, WGM = 8;
__device__ __forceinline__ int lds_byte(int r, int c) { const int st = (r >> 4) * 2 + (c >> 5), rr = r & 15, cc = c & 31, ob = rr * 64 + cc * 2; return st * 1024 + (ob ^ (((ob >> 9) & 1) << 5)); }
__device__ __forceinline__ void stage_rc(int b, int& R, int& C) { const int st = b / 1024, sb = b % 1024, swz = sb ^ (((sb >> 9) & 1) << 5); R = (st >> 1) * 16 + swz / 64; C = (st & 1) * 32 + (swz % 64) / 2; }
__device__ __forceinline__ int perm32(int rho) { const int n = rho >> 4, i = rho & 15; return 8 * (i >> 2) + 4 * n + (i & 3); }
struct Unit { int pm, pn; const char* a; const char* b; int mode; int gcol; };
struct StaticOrder {
  int nM, nN, nwg, G, c;
  __device__ void init(int M, int N, int G_, int c_) { nM = M / BM; nN = N / BM; nwg = nM * nN; G = G_; c = c_; }
  __device__ bool next(int i, int& pm, int& pn) const {
    const long L = (long)i * G + c; if (L >= nwg) return false;
    int wgid = (int)L; { const int q = nwg / NXCD, r = nwg % NXCD, xcd = wgid % NXCD, off = wgid / NXCD; wgid = (xcd < r ? xcd * (q + 1) : r * (q + 1) + (xcd - r) * q) + off; }
    const int nig = WGM * nN, gid = wgid / nig, fm = gid * WGM, gsz = (nM - fm) < WGM ? (nM - fm) : WGM;
    pm = fm + ((wgid % nig) % gsz); pn = (wgid % nig) / gsz; return true;
  }
};
struct Sched {
  int kind; StaticOrder so; const char* gA; const char* gB; size_t tstep; int mode0;
  int n; Unit u0, u1;
  __device__ __forceinline__ bool next(int i, Unit& u) const {
    if (kind == 0) {
      int pm, pn; if (!so.next(i, pm, pn)) return false;
      u.pm = pm; u.pn = pn; u.a = gA + (size_t)pm * tstep; u.b = gB + (size_t)pn * tstep; u.mode = mode0; u.gcol = 0; return true;
    }
    if (i >= n) return false;
    u = (i == 0) ? u0 : u1; return true;
  }
};
struct Epi {
  u16* O16; int ld16; u16* T16; int ldt; const u16* gate; int ldg;
  __device__ __forceinline__ void operator()(const f32x4 (&acc)[2][2][4][2], const Unit& u, int wr, int wc, int fr, int fq) const {
    const int row0 = u.pm * BM + wr * 64 + fr, col0 = u.pn * BM + wc * 64 + 16 * fq;
    const int mode = u.mode;
    if (mode == 5) return;
#pragma unroll
    for (int ai = 0; ai < 2; ++ai)
#pragma unroll
      for (int m = 0; m < 4; ++m) {
        const size_t row = (size_t)(row0 + ai * HALF + m * 16);
#pragma unroll
        for (int bj = 0; bj < 2; ++bj) {
          f32x4 v0 = acc[ai][bj][m][0], v1 = acc[ai][bj][m][1];
          const int col = col0 + bj * 8;
          if (mode != 0) {
            U4 gv = *(const U4*)(gate + row * ldg + u.gcol + col);
            float g8[8];
            unpack8(gv, g8);
            v0[0] *= sigmoid_f(g8[0]); v0[1] *= sigmoid_f(g8[1]); v0[2] *= sigmoid_f(g8[2]); v0[3] *= sigmoid_f(g8[3]);
            v1[0] *= sigmoid_f(g8[4]); v1[1] *= sigmoid_f(g8[5]); v1[2] *= sigmoid_f(g8[6]); v1[3] *= sigmoid_f(g8[7]);
            if (mode == 3) {
              float t8[8];
              unpack8(*(const U4*)(T16 + row * ldt + col), t8);
              v0[0] += t8[0]; v0[1] += t8[1]; v0[2] += t8[2]; v0[3] += t8[3];
              v1[0] += t8[4]; v1[1] += t8[5]; v1[2] += t8[6]; v1[3] += t8[7];
            }
          }
          U4 w; w.x = cvt_pk_bf16(v0[0], v0[1]); w.y = cvt_pk_bf16(v0[2], v0[3]); w.z = cvt_pk_bf16(v1[0], v1[1]); w.w = cvt_pk_bf16(v1[2], v1[3]);
          u16* dst = (mode == 2) ? (T16 + row * ldt + col) : (O16 + paddr(row, col));
#ifdef NT_STORE
          __builtin_nontemporal_store(w, (U4*)dst);
#else
          *(U4*)dst = w;
#endif
        }
      }
  }
};
__device__ __forceinline__ void gemm_phase(LAS unsigned char* lds, int K, const Sched& S, const Epi& E) {
  const int tid = otid512(), wid = __builtin_amdgcn_readfirstlane(tid >> 6), lane = tid & 63, wr = wid >> 2, wc = wid & 3, fr = lane & 15, fq = lane >> 4;
  const int nt = K / BK;
  unsigned voffA[2], voffB[2];
#pragma unroll
  for (int i = 0; i < 2; ++i) {
    const int b_ = tid * 16 + i * 8192; const int R = b_ >> 7; const int C = ((((b_ >> 4) & 7) ^ (R & 7)) * 8);
    const int Rb = (R >> 5) * 64 + ((R >> 2) & 3) * 16 + ((R >> 4) & 1) * 4 + (R & 3);
    voffA[i] = (unsigned)(R * K + C) * 2u; voffB[i] = (unsigned)(Rb * K + C) * 2u; }
  const size_t kstep = (size_t)(BK * 2);
  const size_t hstep = (size_t)HALF * K * 2;
  const size_t hstepB = (size_t)8 * K * 2;
  const unsigned ldsw = (unsigned)wid * 1024u;
  const int aoff = (wr * 64 + fr) * 128, boff = (wc * 32 + fr) * 128;
  const int ck0 = ((fq ^ (fr & 7)) << 4), ck1 = (((4 + fq) ^ (fr & 7)) << 4);
#define PG8_SA(b, h) (((b) * 2 + (h)) * HTB)
#define PG8_SB(b, h) ((4 + (b) * 2 + (h)) * HTB)
#define PG8_STAGE(bufoff, gbase, voff) do { _Pragma("unroll") for (int _i = 0; _i < 2; ++_i) \
    __builtin_amdgcn_global_load_lds((const unsigned*)((const char*)(gbase) + (voff)[_i]), (LAS unsigned*)(lds + (bufoff) + ldsw + _i * 8192), 16, 0, 0); } while (0)
#define PG8_LDA(dst, b, h) do { _Pragma("unroll") for (int m = 0; m < 4; ++m) _Pragma("unroll") for (int k = 0; k < 2; ++k) dst[m][k] = *(const LAS bf16x8*)(lds + PG8_SA(b, h) + aoff + m * 2048 + (k ? ck1 : ck0)); } while (0)
#define PG8_LDB(dst, b, h) do { _Pragma("unroll") for (int n = 0; n < 2; ++n) _Pragma("unroll") for (int k = 0; k < 2; ++k) dst[n][k] = *(const LAS bf16x8*)(lds + PG8_SB(b, h) + boff + n * 2048 + (k ? ck1 : ck0)); } while (0)
#define PG8_MMA(ai, bj, At, Bt) do { __builtin_amdgcn_s_setprio(1); _Pragma("unroll") for (int m = 0; m < 4; ++m) _Pragma("unroll") for (int n = 0; n < 2; ++n) _Pragma("unroll") for (int k = 0; k < 2; ++k) \
    acc[ai][bj][m][n] = __builtin_amdgcn_mfma_f32_16x16x32_bf16(Bt[n][k], At[m][k], acc[ai][bj][m][n], 0, 0, 0); __builtin_amdgcn_s_setprio(0); } while (0)
#define PG8_WAIT_V(n) asm volatile("s_waitcnt vmcnt(" #n ")" ::: "memory")
#define PG8_WAIT_L(n) asm volatile("s_waitcnt lgkmcnt(" #n ")" ::: "memory")
#define PG8_BAR __builtin_amdgcn_s_barrier()
#define PG8_SCHED __builtin_amdgcn_sched_barrier(0)
  Unit cur, nxt; int ui = 0;
  if (!S.next(0, cur)) return;
  f32x4 acc[2][2][4][2];
#pragma unroll
  for (int a = 0; a < 2; ++a)
#pragma unroll
    for (int b = 0; b < 2; ++b)
#pragma unroll
      for (int m = 0; m < 4; ++m)
#pragma unroll
        for (int n = 0; n < 2; ++n) acc[a][b][m][n] = (f32x4){0.f, 0.f, 0.f, 0.f};
  bf16x8 At[4][2], B0[2][2], B1[2][2];
  const char* cA = cur.a; const char* cB = cur.b;
  PG8_STAGE(PG8_SB(0, 0), cB, voffB); PG8_STAGE(PG8_SA(0, 0), cA, voffA); PG8_STAGE(PG8_SB(0, 1), cB + hstepB, voffB); PG8_STAGE(PG8_SA(0, 1), cA + hstep, voffA);
  if (wr == 1) PG8_BAR;
  PG8_WAIT_V(4); PG8_BAR;
  PG8_STAGE(PG8_SB(1, 0), cB + kstep, voffB); PG8_STAGE(PG8_SA(1, 0), cA + kstep, voffA); PG8_STAGE(PG8_SB(1, 1), cB + hstepB + kstep, voffB);
  PG8_WAIT_V(6); PG8_BAR;
  for (;;) {
    const bool has_next = S.next(ui + 1, nxt);
    const char* nA = has_next ? nxt.a : cA; const char* nB = has_next ? nxt.b : cB;
    for (int t = 0; t < nt; t += 2) {
      const bool last = (t == nt - 2);
      const char* a1 = cA + (size_t)(t + 1) * kstep;
      const char* a2 = last ? nA : cA + (size_t)(t + 2) * kstep; const char* b2 = last ? nB : cB + (size_t)(t + 2) * kstep;
      const char* a3 = a2 + kstep; const char* b3 = b2 + kstep;
      PG8_LDB(B0, 0, 0); PG8_SCHED; PG8_LDA(At, 0, 0); PG8_STAGE(PG8_SA(1, 1), a1 + hstep, voffA);
      PG8_WAIT_L(8); PG8_BAR; PG8_WAIT_L(0); PG8_MMA(0, 0, At, B0); PG8_BAR; PG8_SCHED;
      PG8_LDB(B1, 0, 1); PG8_STAGE(PG8_SB(0, 0), b2, voffB);
      PG8_BAR; PG8_WAIT_L(0); PG8_MMA(0, 1, At, B1); PG8_BAR;
      PG8_LDA(At, 0, 1); PG8_STAGE(PG8_SA(0, 0), a2, voffA);
      PG8_BAR; PG8_WAIT_L(0); PG8_MMA(1, 0, At, B0); PG8_BAR; PG8_SCHED;
      PG8_STAGE(PG8_SB(0, 1), b2 + hstepB, voffB);
      PG8_WAIT_V(6); PG8_BAR; PG8_MMA(1, 1, At, B1); PG8_BAR;
      PG8_LDB(B0, 1, 0); PG8_SCHED; PG8_LDA(At, 1, 0); PG8_STAGE(PG8_SA(0, 1), a2 + hstep, voffA);
      PG8_WAIT_L(8); PG8_BAR; PG8_WAIT_L(0); PG8_MMA(0, 0, At, B0); PG8_BAR; PG8_SCHED;
      PG8_LDB(B1, 1, 1); PG8_STAGE(PG8_SB(1, 0), b3, voffB);
      PG8_BAR; PG8_WAIT_L(0); PG8_MMA(0, 1, At, B1); PG8_BAR;
      PG8_LDA(At, 1, 1); PG8_STAGE(PG8_SA(1, 0), a3, voffA);
      PG8_BAR; PG8_WAIT_L(0); PG8_MMA(1, 0, At, B0); PG8_BAR; PG8_SCHED;
      PG8_STAGE(PG8_SB(1, 1), b3 + hstepB, voffB);
      PG8_WAIT_V(6); PG8_BAR; PG8_MMA(1, 1, At, B1); PG8_BAR;
    }
    E(acc, cur, wr, wc, fr, fq);
    if (!has_next) break;
#pragma unroll
    for (int a = 0; a < 2; ++a)
#pragma unroll
      for (int b = 0; b < 2; ++b)
#pragma unroll
        for (int m = 0; m < 4; ++m)
#pragma unroll
          for (int n = 0; n < 2; ++n) acc[a][b][m][n] = (f32x4){0.f, 0.f, 0.f, 0.f};
    cur = nxt; cA = nA; cB = nB; ++ui;
  }
  PG8_WAIT_V(0);
  if (wr == 0) PG8_BAR;
  PG8_BAR;
#undef PG8_SA
#undef PG8_SB
#undef PG8_STAGE
#undef PG8_LDA
#undef PG8_LDB
#undef PG8_MMA
#undef PG8_WAIT_V
#undef PG8_WAIT_L
#undef PG8_BAR
#undef PG8_SCHED
}
}

__device__ void merge_tile8(const Params& p, int layer, int tile, char* smem) {
  const int mt_ = tile % (TC / 256), nt_ = tile / (TC / 256);
  const int t512 = otid512(), lane = t512 & 63, w = t512 >> 6, wr = w >> 1, wc = w & 1;
  f32x4 acc[4][4], tot[4][4];
  zero_acc(tot);
#pragma unroll 1
  for (int br = 0; br < 3; ++br) {
    zero_acc(acc);
    const u16* A; const u16* Bt; int K;
    if (br == 0) { A = p.yssm + (size_t)mt_ * 256 * 1024; Bt = p.PsT + (size_t)layer * 1024 * 1024 + (size_t)nt_ * 128 * 1024; K = 1024; }
    else if (br == 1) { A = p.yattn + (size_t)mt_ * 256 * 512; Bt = p.PaT + (size_t)layer * 1024 * 512 + (size_t)nt_ * 128 * 512; K = 512; }
    else { A = p.ysc + (size_t)mt_ * 256 * 512; Bt = p.PcT + (size_t)layer * 1024 * 512 + (size_t)nt_ * 128 * 512; K = 512; }
    gemm_tile8(A, K, Bt, K, K, acc, smem);
#pragma unroll
    for (int mt = 0; mt < 4; ++mt) {
      const int m = mt_ * 256 + wr * 64 + mt * 16 + (lane & 15);
      const int n = nt_ * 128 + wc * 64 + (lane >> 4) * 16;
      const u16* gp = p.proj + paddr((size_t)m, CM + br * 1024 + n);
      float g16[16];
      unpack8(*(const U4*)gp, g16);
      unpack8(*(const U4*)(gp + 8), g16 + 8);
#pragma unroll
      for (int nt = 0; nt < 4; ++nt)
#pragma unroll
        for (int j = 0; j < 4; ++j) tot[mt][nt][j] += sigmoid_f(g16[nt * 4 + j]) * acc[mt][nt][j];
    }
  }
#pragma unroll
  for (int mt = 0; mt < 4; ++mt) {
    const int m = mt_ * 256 + wr * 64 + mt * 16 + (lane & 15);
    const int n = nt_ * 128 + wc * 64 + (lane >> 4) * 16;
    U4 o0, o1;
    o0.x = pack2(tot[mt][0][0], tot[mt][0][1]); o0.y = pack2(tot[mt][0][2], tot[mt][0][3]);
    o0.z = pack2(tot[mt][1][0], tot[mt][1][1]); o0.w = pack2(tot[mt][1][2], tot[mt][1][3]);
    o1.x = pack2(tot[mt][2][0], tot[mt][2][1]); o1.y = pack2(tot[mt][2][2], tot[mt][2][3]);
    o1.z = pack2(tot[mt][3][0], tot[mt][3][1]); o1.w = pack2(tot[mt][3][2], tot[mt][3][3]);
    u16* dp = p.Pa + (size_t)m * 1024 + n;
    *(U4*)dp = o0; *(U4*)(dp + 8) = o1;
  }
}

__device__ void wout_tile8(const Params& p, int layer, int tile, char* smem) {
  const int mt_ = tile % (TC / 256), nt_ = tile / (TC / 256);
  const int t512 = otid512(), lane = t512 & 63, w = t512 >> 6, wr = w >> 1, wc = w & 1;
  f32x4 acc[4][4];
  zero_acc(acc);
  gemm_tile8(p.Pa + (size_t)mt_ * 256 * 1024, 1024, p.WoT + (size_t)layer * 1024 * 1024 + (size_t)nt_ * 128 * 1024,
             1024, 1024, acc, smem);
#pragma unroll
  for (int mt = 0; mt < 4; ++mt) {
    const int m = mt_ * 256 + wr * 64 + mt * 16 + (lane & 15);
    const int n = nt_ * 128 + wc * 64 + (lane >> 4) * 16;
    U4 o0, o1;
    o0.x = pack2(acc[mt][0][0], acc[mt][0][1]); o0.y = pack2(acc[mt][0][2], acc[mt][0][3]);
    o0.z = pack2(acc[mt][1][0], acc[mt][1][1]); o0.w = pack2(acc[mt][1][2], acc[mt][1][3]);
    o1.x = pack2(acc[mt][2][0], acc[mt][2][1]); o1.y = pack2(acc[mt][2][2], acc[mt][2][3]);
    o1.z = pack2(acc[mt][3][0], acc[mt][3][1]); o1.w = pack2(acc[mt][3][2], acc[mt][3][3]);
    u16* dp = p.outA + (size_t)m * 1024 + n;
    *(U4*)dp = o0; *(U4*)(dp + 8) = o1;
  }
}

__device__ void resid_item(const Params& p, int layer, int ch, int it) {
  const int t512 = otid512();
  const int lane = t512 & 63, w = t512 >> 6;
  const int rl = it * 8 + w;
  const size_t rg = (size_t)ch * TC + rl;
  const float* xs = (layer == 0 ? p.x : p.out) + rg * D_;
  float* xd = p.out + rg * D_;
  const float* wp = p.norm_post + layer * D_;
  f32x4 o[4], xv[4], wv[4];
  float ps = 0.f;
#pragma unroll
  for (int i = 0; i < 4; ++i) {
    int c = (i * 64 + lane) * 4;
    U2 pa = *(const U2*)(p.outA + (size_t)rl * D_ + c);
    xv[i] = *(const f32x4*)(xs + c);
    wv[i] = *(const f32x4*)(wp + c);
    o[i].x = lo2f(pa.x); o[i].y = hi2f(pa.x); o[i].z = lo2f(pa.y); o[i].w = hi2f(pa.y);
    ps += o[i].x * o[i].x + o[i].y * o[i].y + o[i].z * o[i].z + o[i].w * o[i].w;
  }
  ps = wave_sum(ps);
  const float rstd = rsqrtf(ps * (1.f / D_) + EPS);
  f32x4 v[4];
  float ss = 0.f;
#pragma unroll
  for (int i = 0; i < 4; ++i) {
    int c = (i * 64 + lane) * 4;
    v[i] = xv[i] + o[i] * rstd * wv[i];
    *(f32x4*)(xd + c) = v[i];
    ss += v[i].x * v[i].x + v[i].y * v[i].y + v[i].z * v[i].z + v[i].w * v[i].w;
  }
  if (layer == 0) {
    ss = wave_sum(ss);
    float r2 = rsqrtf(ss * (1.f / D_) + EPS);
#pragma unroll
    for (int i = 0; i < 4; ++i) {
      U2 ov;
      ov.x = pack2(v[i].x * r2, v[i].y * r2);
      ov.y = pack2(v[i].z * r2, v[i].w * r2);
      *(U2*)(p.h + rg * D_ + (i * 64 + lane) * 4) = ov;
    }
  }
}

__device__ __forceinline__ void dt_cs_setup(const Params& p, int layer, size_t R0, int g, float* cs_s, float* dt_s,
                                            float& cs_last_out) {
  const int lane = otid() & 63, w = otid() >> 6;
  const int hd = g * 4 + w;
  const float bias = p.dt_bias[layer * 16 + hd];
  const float aneg = -__expf(p.a_log[layer * 16 + hd]);
  float d0 = softplus_f(bf2f(p.proj[paddr(R0 + lane, CDT + hd)]) + bias);
  float d1 = softplus_f(bf2f(p.proj[paddr(R0 + 64 + lane, CDT + hd)]) + bias);
  float c0 = d0 * aneg, c1 = d1 * aneg;
#pragma unroll
  for (int o = 1; o < 64; o <<= 1) {
    float t0 = __shfl_up(c0, o, 64), t1 = __shfl_up(c1, o, 64);
    if (lane >= o) { c0 += t0; c1 += t1; }
  }
  float tot0 = __shfl(c0, 63, 64);
  c1 += tot0;
  cs_last_out = __shfl(c1, 63, 64);
  cs_s[w * 128 + lane] = c0;
  cs_s[w * 128 + 64 + lane] = c1;
  dt_s[w * 128 + lane] = d0;
  dt_s[w * 128 + 64 + lane] = d1;
}

template <int NT>
__device__ __forceinline__ void conv_load(const u16* proj, size_t row0, int col, int tin0, U4 (&rows)[NT + 3]) {
#pragma unroll
  for (int i = 0; i < NT + 3; ++i) {
    const bool ok = (tin0 + i - 3) >= 0;
    U4 v = *(const U4*)(proj + paddr(ok ? row0 + i - 3 : row0, col));
    rows[i] = ok ? v : U4{0u, 0u, 0u, 0u};
  }
}
template <int NT, class F>
__device__ __forceinline__ void conv_compute(const U4 (&rows)[NT + 3], const float* cw, const float* cb, F&& emit) {
  f32x4 w0[4], w1[4];
#pragma unroll
  for (int k = 0; k < 4; ++k) { w0[k] = *(const f32x4*)(cw + k * 2048); w1[k] = *(const f32x4*)(cw + k * 2048 + 4); }
  const f32x4 b0 = *(const f32x4*)cb, b1 = *(const f32x4*)(cb + 4);
  float win[4][8];
  unpack8(rows[0], win[0]); unpack8(rows[1], win[1]); unpack8(rows[2], win[2]);
#pragma unroll
  for (int t = 0; t < NT; ++t) {
    unpack8(rows[t + 3], win[(t + 3) & 3]);
    float a8[8] = {b0.x, b0.y, b0.z, b0.w, b1.x, b1.y, b1.z, b1.w};
#pragma unroll
    for (int k = 0; k < 4; ++k) {
      const float* v8 = win[(t + k) & 3];
      a8[0] += w0[k].x * v8[0]; a8[1] += w0[k].y * v8[1]; a8[2] += w0[k].z * v8[2]; a8[3] += w0[k].w * v8[3];
      a8[4] += w1[k].x * v8[4]; a8[5] += w1[k].y * v8[5]; a8[6] += w1[k].z * v8[6]; a8[7] += w1[k].w * v8[7];
    }
#pragma unroll
    for (int e = 0; e < 8; ++e) a8[e] = silu_f(a8[e]);
    emit(t, a8);
  }
}

__device__ void ssd_passA(const Params& p, int layer, int it, char* smem) {
  const int tid = otid(), lane = tid & 63, w = __builtin_amdgcn_readfirstlane(tid >> 6);
  const int hp = it & 1, g = (it >> 1) & 3, c = (it >> 3) & 31, bl = it >> 8;
  const size_t R0 = (size_t)bl * S_ + c * 128;
  u16* Bt = (u16*)smem;
  u16* Xt = Bt + 128 * 136;
  float* cs_s = (float*)(smem + 69632);
  float* wg_s = cs_s + 256;
  const int hd0 = g * 4 + hp * 2;
  if (w < 2) {
    const int hd = hd0 + w;
    const float bias = p.dt_bias[layer * 16 + hd];
    const float aneg = -__expf(p.a_log[layer * 16 + hd]);
    float d0 = softplus_f(bf2f(p.proj[paddr(R0 + lane, CDT + hd)]) + bias);
    float d1 = softplus_f(bf2f(p.proj[paddr(R0 + 64 + lane, CDT + hd)]) + bias);
    float c0 = d0 * aneg, c1 = d1 * aneg;
#pragma unroll
    for (int o = 1; o < 64; o <<= 1) {
      float t0 = __shfl_up(c0, o, 64), t1 = __shfl_up(c1, o, 64);
      if (lane >= o) { c0 += t0; c1 += t1; }
    }
    c1 += __shfl(c0, 63, 64);
    const float cs_last = __shfl(c1, 63, 64);
    wg_s[w * 128 + lane] = d0 * __expf(cs_last - c0);
    wg_s[w * 128 + 64 + lane] = d1 * __expf(cs_last - c1);
    if (lane == 0) p.dec[((size_t)bl * 32 + c) * 16 + hd] = __expf(cs_last);
  }
  const float* cw = p.ssm_conv_w + (size_t)layer * 4 * 2048;
  const float* cb = p.ssm_conv_b + (size_t)layer * 2048;
  {
    const int chunk = tid & 31, tg = tid >> 5;
    const int chn = (chunk < 16) ? (hd0 * 64 + chunk * 8) : (1024 + g * 128 + (chunk - 16) * 8);
    u16* dst = (chunk < 16) ? (Xt + (chunk * 8) * 136) : (Bt + ((chunk - 16) * 8) * 136);
    const int t0 = tg * 16;
    const int chunkc = tid & 7, tgc = tid >> 3;
    const int chnc = 1536 + g * 128 + (hp * 8 + chunkc) * 8;
    const int t0c = tgc * 4;
    U4 rxb[19], rcc[7];
    conv_load<16>(p.proj, R0 + t0, CX + chn, c * 128 + t0, rxb);
    conv_load<4>(p.proj, R0 + t0c, CX + chnc, c * 128 + t0c, rcc);
    u16* xo = p.xc + (R0 + t0) * 2048 + chn;
    conv_compute<16>(rxb, cw + chn, cb + chn, [&](int t, const float* a8) {
      U4 ov = pack8(a8);
      *(U4*)(xo + (size_t)t * 2048) = ov;
      const int tok = t0 + t;
      u16* d = dst + ((((tok >> 3) ^ (chunk & 15)) << 3) | (tok & 7));
      d[0 * 136] = (u16)(ov.x & 0xffff); d[1 * 136] = (u16)(ov.x >> 16);
      d[2 * 136] = (u16)(ov.y & 0xffff); d[3 * 136] = (u16)(ov.y >> 16);
      d[4 * 136] = (u16)(ov.z & 0xffff); d[5 * 136] = (u16)(ov.z >> 16);
      d[6 * 136] = (u16)(ov.w & 0xffff); d[7 * 136] = (u16)(ov.w >> 16);
    });
    u16* xoc = p.xc + (R0 + t0c) * 2048 + chnc;
    conv_compute<4>(rcc, cw + chnc, cb + chnc, [&](int t, const float* a8) {
      *(U4*)(xoc + (size_t)t * 2048) = pack8(a8);
    });
  }
  __syncthreads();
#pragma unroll
  for (int i = 0; i < 4; ++i) {
    const int q = tid + 256 * i;
    const int row = q >> 3, grp = q & 7, sw = (row >> 3) & 15;
    const U4 a = *(const U4*)(Xt + row * 136 + (((2 * grp) ^ sw) << 3));
    const U4 b = *(const U4*)(Xt + row * 136 + (((2 * grp + 1) ^ sw) << 3));
    const size_t sx = ((size_t)bl * 32 + c) * 16 + hd0 + (row >> 6);
    u16* d = p.xT + sx * 8192 + (size_t)(row & 63) * 128 + grp * 16;
    U4 o0, o1;
    o0.x = a.x; o0.y = a.y; o0.z = b.x; o0.w = b.y;
    o1.x = a.z; o1.y = a.w; o1.z = b.z; o1.w = b.w;
    *(U4*)d = o0; *(U4*)(d + 8) = o1;
  }
  const int hl = w >> 1, nh = w & 1;
  const int r31 = lane & 31, hh = lane >> 5;
  f32x16 acc[2][2];
#pragma unroll
  for (int a = 0; a < 2; ++a)
#pragma unroll
    for (int b = 0; b < 2; ++b)
#pragma unroll
      for (int r = 0; r < 16; ++r) acc[a][b][r] = 0.f;
#pragma unroll 2
  for (int s = 0; s < 8; ++s) {
    float wv[8];
#pragma unroll
    for (int e = 0; e < 8; ++e) wv[e] = wg_s[hl * 128 + s * 16 + hh * 8 + e];
    bf16x8 xf[2];
#pragma unroll
    for (int pt = 0; pt < 2; ++pt) {
      const int xr = hl * 64 + pt * 32 + r31;
      U4 raw = *(const U4*)(Xt + xr * 136 + (((s * 2 + hh) ^ ((xr >> 3) & 15)) << 3));
      float v8[8];
      unpack8(raw, v8);
#pragma unroll
      for (int e = 0; e < 8; ++e) v8[e] *= wv[e];
      xf[pt] = as_bf16x8(pack8(v8));
    }
#pragma unroll
    for (int nt = 0; nt < 2; ++nt) {
      const int br = nh * 64 + nt * 32 + (((r31 >> 2) & 1) * 16 + (r31 & 3) + 4 * (r31 >> 3));
      bf16x8 bfr = ld_frag(Bt + br * 136 + (((s * 2 + hh) ^ ((br >> 3) & 15)) << 3));
#pragma unroll
      for (int pt = 0; pt < 2; ++pt) acc[nt][pt] = mfma32(bfr, xf[pt], acc[nt][pt]);
    }
  }
  {
    const size_t sidx = ((size_t)bl * 32 + c) * 16 + hd0 + hl;
#pragma unroll
    for (int nt = 0; nt < 2; ++nt)
#pragma unroll
      for (int pt = 0; pt < 2; ++pt)
#pragma unroll
        for (int h2 = 0; h2 < 2; ++h2) {
          U4 v;
          v.x = pack2(acc[nt][pt][h2 * 8 + 0], acc[nt][pt][h2 * 8 + 1]);
          v.y = pack2(acc[nt][pt][h2 * 8 + 2], acc[nt][pt][h2 * 8 + 3]);
          v.z = pack2(acc[nt][pt][h2 * 8 + 4], acc[nt][pt][h2 * 8 + 5]);
          v.w = pack2(acc[nt][pt][h2 * 8 + 6], acc[nt][pt][h2 * 8 + 7]);
          *(U4*)(p.stloc + sidx * 8192 + (size_t)(pt * 32 + r31) * 128 + nh * 64 + nt * 32 + hh * 16 + h2 * 8) = v;
        }
  }
  __syncthreads();
}

__device__ void ssd_scan_item(const Params& p, int it) {
  const int q = it * 512 + otid512();
  const int e2 = q & 4095, bh = q >> 12;
  const int bl = bh >> 4, hd = bh & 15;
  u32 lv[32];
  float dv[32];
#pragma unroll
  for (int c = 0; c < 32; ++c) {
    const size_t sidx = ((size_t)bl * 32 + c) * 16 + hd;
    lv[c] = *(const u32*)(p.stloc + sidx * 8192 + e2 * 2);
    dv[c] = p.dec[sidx];
  }
  float s0 = 0.f, s1 = 0.f;
#pragma unroll
  for (int c = 0; c < 32; ++c) {
    const size_t sidx = ((size_t)bl * 32 + c) * 16 + hd;
    *(u32*)(p.prev + sidx * 8192 + e2 * 2) = pack2(s0, s1);
    s0 = s0 * dv[c] + lo2f(lv[c]);
    s1 = s1 * dv[c] + hi2f(lv[c]);
  }
}

__device__ void ssd_passC(const Params& p, int layer, int it, char* smem) {
  const int tid = otid(), lane = tid & 63, w = __builtin_amdgcn_readfirstlane(tid >> 6);
  const int lh = it & 1, g = (it >> 1) & 3, c = (it >> 3) & 31, bl = it >> 8;
  const size_t R0 = (size_t)bl * S_ + c * 128;
  float* cs_s = (float*)smem;
  float* dt_s = cs_s + 512;
  float* ssq_s = (float*)(smem + 4096);
  const int strip = w >> 1, hp = w & 1;
  const int ntile = lh * 2 + strip + 1;
  const int r31 = lane & 31, hh = lane >> 5;
  const int l = (ntile - 1) * 32 + r31;
  bf16x8 cf[8];
  {
    const u16* cp = p.xc + (R0 + l) * 2048 + 1536 + g * 128 + hh * 8;
#pragma unroll
    for (int s = 0; s < 8; ++s) cf[s] = ld_frag(cp + s * 16);
  }
  {
    float dummy;
    dt_cs_setup(p, layer, R0, g, cs_s, dt_s, dummy);
  }
  __syncthreads();
  f32x16 gacc[4];
#pragma unroll
  for (int st = 0; st < 4; ++st) {
#pragma unroll
    for (int r = 0; r < 16; ++r) gacc[st][r] = 0.f;
    if (st < ntile) {
      const u16* bp = p.xc + (R0 + st * 32 + r31) * 2048 + 1024 + g * 128 + hh * 8;
#pragma unroll
      for (int s = 0; s < 8; ++s) gacc[st] = mfma32(ld_frag(bp + s * 16), cf[s], gacc[st]);
    }
  }
  U4* ypk = (U4*)(smem + 8192) + tid;
  float ssq = 0.f;
  const u16* xrow = p.xc + (R0 + l) * 2048;
  u16* yrow = p.yssm + (R0 + l) * 1024;
  const int pir = ((r31 >> 2) & 1) * 16 + (r31 & 3) + 4 * (r31 >> 3);
  const int loff = pir * 128 + hh * 8;
  const int xoff = pir * 128 + hh * 8;
#pragma unroll 1
  for (int j = 0; j < 2; ++j) {
    int hd = g * 4 + hp * 2 + j;
    asm volatile("" : "+s"(hd));
    const size_t sb = (((size_t)bl * 32 + c) * 16 + hd) * 8192;
    const u16* prevj = p.prev + sb;
    const u16* xTj = p.xT + sb;
    const float* csj = cs_s + (hd & 3) * 128;
    const float* dtj = dt_s + (hd & 3) * 128;
    f32x16 y[2];
#pragma unroll
    for (int pt = 0; pt < 2; ++pt) {
#pragma unroll
      for (int r = 0; r < 16; ++r) y[pt][r] = 0.f;
    }
#pragma unroll
    for (int s2 = 0; s2 < 4; ++s2) {
      bf16x8 f00 = ld_frag(prevj + loff + (2 * s2) * 16), f01 = ld_frag(prevj + loff + (2 * s2 + 1) * 16);
      bf16x8 f10 = ld_frag(prevj + loff + 32 * 128 + (2 * s2) * 16), f11 = ld_frag(prevj + loff + 32 * 128 + (2 * s2 + 1) * 16);
      y[0] = mfma32(f00, cf[2 * s2], y[0]);
      y[1] = mfma32(f10, cf[2 * s2], y[1]);
      y[0] = mfma32(f01, cf[2 * s2 + 1], y[0]);
      y[1] = mfma32(f11, cf[2 * s2 + 1], y[1]);
    }
    const float csl = csj[l];
    const float el = __expf(csl);
#pragma unroll
    for (int pt = 0; pt < 2; ++pt)
#pragma unroll
      for (int r = 0; r < 16; ++r) y[pt][r] *= el;
#pragma unroll
    for (int st = 0; st < 4; ++st) {
      if (st < ntile) {
#pragma unroll
        for (int ks = 0; ks < 2; ++ks) {
          float m8[8];
          {
            const int sb0 = 4 * hh + st * 32 + ks * 16;
            const f32x4 ca = *(const f32x4*)(csj + sb0), cb2 = *(const f32x4*)(csj + sb0 + 8);
            const f32x4 da = *(const f32x4*)(dtj + sb0), db2 = *(const f32x4*)(dtj + sb0 + 8);
#pragma unroll
            for (int jj = 0; jj < 4; ++jj) {
              m8[jj] = gacc[st][ks * 8 + jj] * __expf(csl - ca[jj]) * da[jj];
              m8[4 + jj] = gacc[st][ks * 8 + 4 + jj] * __expf(csl - cb2[jj]) * db2[jj];
            }
            if (st == ntile - 1) {
#pragma unroll
              for (int jj = 0; jj < 8; ++jj) {
                const int sloc = ks * 16 + 8 * (jj >> 2) + (jj & 3) + 4 * hh;
                m8[jj] = (sloc <= r31) ? m8[jj] : 0.f;
              }
            }
          }
          bf16x8 pf = as_bf16x8(pack8(m8));
#pragma unroll
          for (int pt = 0; pt < 2; ++pt) {
            const u16* xp = xTj + xoff + (pt * 32 * 128 + st * 32 + ks * 16);
            const U4 xv = *(const U4*)xp;
            y[pt] = mfma32(as_bf16x8(xv), pf, y[pt]);
          }
        }
      }
    }
    const float dsk = p.d_skip[layer * 16 + hd];
    const u16* xh = xrow + hd * 64 + hh * 16;
    const u16* zh = p.proj + paddr(R0 + l, CZ + hd * 64) + hh * 16;
    U4* ypj = ypk + (hd & 1) * 4 * 256;
#pragma unroll
    for (int pt = 0; pt < 2; ++pt) {
      float x16[16], z16[16], v16[16];
      unpack8(*(const U4*)(xh + pt * 32), x16); unpack8(*(const U4*)(xh + pt * 32 + 8), x16 + 8);
      unpack8(*(const U4*)(zh + pt * 32), z16); unpack8(*(const U4*)(zh + pt * 32 + 8), z16 + 8);
#pragma unroll
      for (int r = 0; r < 16; ++r) {
        v16[r] = (y[pt][r] + dsk * x16[r]) * silu_f(z16[r]);
        ssq += v16[r] * v16[r];
      }
      ypj[(pt * 2 + 0) * 256] = pack8(v16);
      ypj[(pt * 2 + 1) * 256] = pack8(v16 + 8);
    }
  }
  ssq += __shfl_xor(ssq, 32, 64);
  if (hh == 0) ssq_s[w * 32 + r31] = ssq;
  __syncthreads();
  ssq = ssq_s[w * 32 + r31] + ssq_s[(w ^ 1) * 32 + r31];
  const float rstd = rsqrtf(ssq * (1.f / 256.f) + EPS);
#pragma unroll 1
  for (int j = 0; j < 2; ++j) {
    int hd = g * 4 + hp * 2 + j;
    asm volatile("" : "+s"(hd));
    const float* nwp = p.ssm_norm + layer * 1024 + hd * 64 + hh * 16;
    u16* yh = yrow + hd * 64 + hh * 16;
    const U4* ypj = ypk + (hd & 1) * 4 * 256;
#pragma unroll
    for (int pt = 0; pt < 2; ++pt)
#pragma unroll
      for (int h2 = 0; h2 < 2; ++h2) {
        const f32x4 nw0 = *(const f32x4*)(nwp + pt * 32 + h2 * 8), nw1 = *(const f32x4*)(nwp + pt * 32 + h2 * 8 + 4);
        float v8[8];
        unpack8(ypj[(pt * 2 + h2) * 256], v8);
        v8[0] *= rstd * nw0.x; v8[1] *= rstd * nw0.y; v8[2] *= rstd * nw0.z; v8[3] *= rstd * nw0.w;
        v8[4] *= rstd * nw1.x; v8[5] *= rstd * nw1.y; v8[6] *= rstd * nw1.z; v8[7] *= rstd * nw1.w;
        *(U4*)(yh + pt * 32 + h2 * 8) = pack8(v8);
      }
  }
  __syncthreads();
}

__device__ __forceinline__ void attn_load(const Params& p, int it, int tid, U4 (&kreg)[8], U4 (&vreg)[8]) {
  const int blk = it & 31;
  int t2 = it >> 5;
  const int g = t2 % 3; t2 /= 3;
  const int kvh = t2 & 7, bl = t2 >> 3;
  const int dsh = 2 * g, d = 1 << dsh, nper = 32 >> dsh;
  const int r = blk / nper, n = blk % nper;
  const size_t Rb = (size_t)bl * S_;
#pragma unroll
  for (int i = 0; i < 8; ++i) {
    const int q = tid + 256 * i;
    const int row = q >> 3, chk = q & 7;
    const int ik = (n - 1) * 128 + row;
    const bool ok = ik >= 0;
    const size_t krow = Rb + (size_t)(ok ? ik : 0) * d + r;
    U4 kv = *(const U4*)(p.proj + paddr(krow, CK + kvh * 64 + chk * 8));
    U4 vv = *(const U4*)(p.proj + paddr(krow, CV + kvh * 64 + chk * 8));
    kreg[i] = ok ? kv : U4{0u, 0u, 0u, 0u};
    vreg[i] = ok ? vv : U4{0u, 0u, 0u, 0u};
  }
}

__device__ void attn_item(const Params& p, int it, int it_next, U4 (&kreg)[8], U4 (&vreg)[8], char* smem) {
  const int tid = otid(), lane = tid & 63, w = tid >> 6;
  const int blk = it & 31;
  int t2 = it >> 5;
  const int g = t2 % 3; t2 /= 3;
  const int kvh = t2 & 7, bl = t2 >> 3;
  const int dsh = 2 * g;
  const int d = 1 << dsh;
  const int nper = 32 >> dsh;
  const int r = blk / nper, n = blk % nper;
  u16* Ks = (u16*)smem;
  u16* Vs = Ks + 256 * 72;
  const size_t Rb = (size_t)bl * S_;
#pragma unroll
  for (int i = 0; i < 8; ++i) {
    int q = tid + 256 * i;
    int row = q >> 3, chk = q & 7;
    *(U4*)(Ks + row * 72 + chk * 8) = kreg[i];
    *(U4*)(Vs + row * 72 + chk * 8) = vreg[i];
  }
  const int r31 = lane & 31, hh = lane >> 5;
  const int iq = 32 * w + r31;
  const size_t rq_row = Rb + (size_t)(n * 128 + iq) * d + r;
  bf16x8 qf[4];
  {
    const u16* qp = p.proj + paddr(rq_row, CQ + g * 512 + kvh * 64) + hh * 8;
#pragma unroll
    for (int s = 0; s < 4; ++s) qf[s] = ld_frag(qp + s * 16);
  }
  __syncthreads();
  if (it_next >= 0) attn_load(p, it_next, tid, kreg, vreg);
  f32x16 sacc[5];
#pragma unroll
  for (int kt = 0; kt < 5; ++kt) {
#pragma unroll
    for (int rr = 0; rr < 16; ++rr) sacc[kt][rr] = 0.f;
    const u16* kp = Ks + (32 * (w + kt) + r31) * 72 + hh * 8;
#pragma unroll
    for (int s = 0; s < 4; ++s) sacc[kt] = mfma32(ld_frag(kp + s * 16), qf[s], sacc[kt]);
  }
  {
    const int tq = r31 - 4 * hh;
#pragma unroll
    for (int rr = 0; rr < 16; ++rr) {
      const int c = (rr & 3) + 8 * (rr >> 2);
      if (c < tq) sacc[0][rr] = -INFINITY;
      if (c > tq) sacc[4][rr] = -INFINITY;
    }
    if (n == 0) {
#pragma unroll
      for (int kt = 0; kt < 5; ++kt)
#pragma unroll
        for (int rr = 0; rr < 16; ++rr) {
          const int kk = 32 * (w + kt) + (rr & 3) + 8 * (rr >> 2) + 4 * hh;
          if (kk < 128) sacc[kt][rr] = -INFINITY;
        }
    }
  }
  float mx = -INFINITY;
#pragma unroll
  for (int kt = 0; kt < 5; ++kt)
#pragma unroll
    for (int rr = 0; rr < 16; ++rr) mx = fmaxf(mx, sacc[kt][rr]);
  mx = fmaxf(mx, __shfl_xor(mx, 32, 64));
  const float c2 = 0.125f * 1.4426950408889634f;
  const float mb = mx * c2;
  float den = 0.f;
#pragma unroll
  for (int kt = 0; kt < 5; ++kt)
#pragma unroll
    for (int rr = 0; rr < 16; ++rr) {
      float e = __builtin_amdgcn_exp2f(__builtin_fmaf(sacc[kt][rr], c2, -mb));
      sacc[kt][rr] = e;
      den += e;
    }
  den += __shfl_xor(den, 32, 64);
  f32x16 o[2];
#pragma unroll
  for (int et = 0; et < 2; ++et)
#pragma unroll
    for (int rr = 0; rr < 16; ++rr) o[et][rr] = 0.f;
#pragma unroll
  for (int kt = 0; kt < 5; ++kt)
#pragma unroll
    for (int ks = 0; ks < 2; ++ks) {
      float p8[8];
#pragma unroll
      for (int jj = 0; jj < 8; ++jj) p8[jj] = sacc[kt][ks * 8 + jj];
      bf16x8 pf = as_bf16x8(pack8(p8));
#pragma unroll
      for (int et = 0; et < 2; ++et) {
        const int trq = (lane & 15) >> 2, trp = lane & 3, trg = (lane >> 4) & 1;
        const u16* vp = Vs + (32 * (w + kt) + 16 * ks + 4 * hh + trq) * 72 + et * 32 + 16 * (trp & 1) + 8 * trg + 4 * (trp >> 1);
        typedef short v4s_t __attribute__((ext_vector_type(4)));
        v4s_t v0 = __builtin_amdgcn_ds_read_tr16_b64_v4i16((LAS v4s_t*)vp);
        v4s_t v1 = __builtin_amdgcn_ds_read_tr16_b64_v4i16((LAS v4s_t*)(vp + 8 * 72));
        bf16x8 vfr;
        vfr[0] = v0[0]; vfr[1] = v0[1]; vfr[2] = v0[2]; vfr[3] = v0[3];
        vfr[4] = v1[0]; vfr[5] = v1[1]; vfr[6] = v1[2]; vfr[7] = v1[3];
        o[et] = mfma32(vfr, pf, o[et]);
      }
    }
  const float inv = __builtin_amdgcn_rcpf(den);
  const size_t rloc = rq_row;
  u16* op = p.og + ((size_t)g * TC + rloc) * 512 + kvh * 64;
#pragma unroll
  for (int et = 0; et < 2; ++et)
#pragma unroll
    for (int h2 = 0; h2 < 2; ++h2) {
      U4 ov;
      ov.x = pack2(o[et][h2 * 8 + 0] * inv, o[et][h2 * 8 + 1] * inv);
      ov.y = pack2(o[et][h2 * 8 + 2] * inv, o[et][h2 * 8 + 3] * inv);
      ov.z = pack2(o[et][h2 * 8 + 4] * inv, o[et][h2 * 8 + 5] * inv);
      ov.w = pack2(o[et][h2 * 8 + 6] * inv, o[et][h2 * 8 + 7] * inv);
      *(U4*)(op + et * 32 + hh * 16 + h2 * 8) = ov;
    }
  if (hh == 0) p.lse[((size_t)g * TC + rloc) * 8 + kvh] = mx * 0.125f + __logf(den);
  __syncthreads();
}

__device__ void attn_combine_item(const Params& p, int it) {
  const int t512 = otid512();
  const int chk = t512 & 63, kvh = chk >> 3;
  float l0[4], l1[4], l2[4];
  U4 ra[4], rb[4], rc[4], rg[4];
#pragma unroll
  for (int i = 0; i < 4; ++i) {
    const size_t row = (size_t)((it * 4 + i) * 512 + t512) >> 6;
    l0[i] = p.lse[((size_t)0 * TC + row) * 8 + kvh];
    l1[i] = p.lse[((size_t)1 * TC + row) * 8 + kvh];
    l2[i] = p.lse[((size_t)2 * TC + row) * 8 + kvh];
    ra[i] = *(const U4*)(p.og + ((size_t)0 * TC + row) * 512 + chk * 8);
    rb[i] = *(const U4*)(p.og + ((size_t)1 * TC + row) * 512 + chk * 8);
    rc[i] = *(const U4*)(p.og + ((size_t)2 * TC + row) * 512 + chk * 8);
    rg[i] = *(const U4*)(p.proj + paddr(row, CGA + chk * 8));
  }
#pragma unroll
  for (int i = 0; i < 4; ++i) {
    const size_t row = (size_t)((it * 4 + i) * 512 + t512) >> 6;
    float m = fmaxf(l0[i], fmaxf(l1[i], l2[i]));
    float e0 = __expf(l0[i] - m), e1 = __expf(l1[i] - m), e2 = __expf(l2[i] - m);
    float inv = __builtin_amdgcn_rcpf(e0 + e1 + e2);
    e0 *= inv; e1 *= inv; e2 *= inv;
    float a[8], b[8], c[8], gt[8], o[8];
    unpack8(ra[i], a); unpack8(rb[i], b); unpack8(rc[i], c); unpack8(rg[i], gt);
#pragma unroll
    for (int e = 0; e < 8; ++e) o[e] = (e0 * a[e] + e1 * b[e] + e2 * c[e]) * silu_f(gt[e]);
    *(U4*)(p.yattn + row * 512 + chk * 8) = pack8(o);
  }
}

__device__ void shortconv_item(const Params& p, int layer, int it) {
  const float* cw = p.sc_conv_w + (size_t)layer * 3 * 512;
  const int t512 = otid512();
  const int chk = t512 & 63;
  f32x4 w0[3], w1[3];
#pragma unroll
  for (int k = 0; k < 3; ++k) { w0[k] = *(const f32x4*)(cw + k * 512 + chk * 8); w1[k] = *(const f32x4*)(cw + k * 512 + chk * 8 + 4); }
#pragma unroll
  for (int ip = 0; ip < 1; ++ip) {
    U4 ru[4][3], rc[4][3], rb[4], rgs[4];
#pragma unroll
    for (int j = 0; j < 4; ++j) {
      const size_t row = (size_t)((it * 4 + j) * 512 + t512) >> 6;
      const int tin = (int)(row & (S_ - 1));
#pragma unroll
      for (int k = 0; k < 3; ++k) {
        const bool ok = tin - 2 + k >= 0;
        const size_t rr = ok ? row - 2 + k : row;
        U4 u = *(const U4*)(p.proj + paddr(rr, CU + chk * 8));
        U4 c = *(const U4*)(p.proj + paddr(rr, CCS + chk * 8));
        ru[j][k] = ok ? u : U4{0u, 0u, 0u, 0u};
        rc[j][k] = ok ? c : U4{0u, 0u, 0u, 0u};
      }
      rb[j] = *(const U4*)(p.proj + paddr(row, CBS + chk * 8));
      rgs[j] = *(const U4*)(p.proj + paddr(row, CGS + chk * 8));
    }
#pragma unroll
    for (int j = 0; j < 4; ++j) {
      const size_t row = (size_t)((it * 4 + j) * 512 + t512) >> 6;
      float acc[8];
#pragma unroll
      for (int e = 0; e < 8; ++e) acc[e] = 0.f;
#pragma unroll
      for (int k = 0; k < 3; ++k) {
        float u8[8], c8[8];
        unpack8(ru[j][k], u8); unpack8(rc[j][k], c8);
        acc[0] += w0[k].x * (c8[0] * u8[0]); acc[1] += w0[k].y * (c8[1] * u8[1]);
        acc[2] += w0[k].z * (c8[2] * u8[2]); acc[3] += w0[k].w * (c8[3] * u8[3]);
        acc[4] += w1[k].x * (c8[4] * u8[4]); acc[5] += w1[k].y * (c8[5] * u8[5]);
        acc[6] += w1[k].z * (c8[6] * u8[6]); acc[7] += w1[k].w * (c8[7] * u8[7]);
      }
      float b8[8], g8[8], o[8];
      unpack8(rb[j], b8); unpack8(rgs[j], g8);
#pragma unroll
      for (int e = 0; e < 8; ++e) o[e] = b8[e] * acc[e] * silu_f(g8[e]);
      *(U4*)(p.ysc + row * 512 + chk * 8) = pack8(o);
    }
  }
}

struct ScanSt { u32 lv[32]; float dv[32]; };
struct CombSt { float l0[4], l1[4], l2[4]; U4 ra[4], rb[4], rc[4], rg[4]; };
struct ResSt { f32x4 o[4], xv[4], wv[4]; };
__device__ __forceinline__ void scan_load(const Params& p, int it, int t512, ScanSt& st) {
  const int q = it * 512 + t512;
  const int e2 = q & 4095, bh = q >> 12, bl = bh >> 4, hd = bh & 15;
#pragma unroll
  for (int c = 0; c < 32; ++c) {
    const size_t sidx = ((size_t)bl * 32 + c) * 16 + hd;
    st.lv[c] = *(const u32*)(p.stloc + sidx * 8192 + e2 * 2);
    st.dv[c] = p.dec[sidx];
  }
}
__device__ __forceinline__ void scan_fin(const Params& p, int it, int t512, const ScanSt& st) {
  const int q = it * 512 + t512;
  const int e2 = q & 4095, bh = q >> 12, bl = bh >> 4, hd = bh & 15;
  float s0 = 0.f, s1 = 0.f;
#pragma unroll
  for (int c = 0; c < 32; ++c) {
    const size_t sidx = ((size_t)bl * 32 + c) * 16 + hd;
    *(u32*)(p.prev + sidx * 8192 + e2 * 2) = pack2(s0, s1);
    s0 = s0 * st.dv[c] + lo2f(st.lv[c]);
    s1 = s1 * st.dv[c] + hi2f(st.lv[c]);
  }
}
__device__ __forceinline__ void comb_load(const Params& p, int it, int t512, CombSt& st) {
  const int chk = t512 & 63, kvh = chk >> 3;
#pragma unroll
  for (int i = 0; i < 4; ++i) {
    const size_t row = (size_t)((it * 4 + i) * 512 + t512) >> 6;
    st.l0[i] = p.lse[((size_t)0 * TC + row) * 8 + kvh];
    st.l1[i] = p.lse[((size_t)1 * TC + row) * 8 + kvh];
    st.l2[i] = p.lse[((size_t)2 * TC + row) * 8 + kvh];
    st.ra[i] = *(const U4*)(p.og + ((size_t)0 * TC + row) * 512 + chk * 8);
    st.rb[i] = *(const U4*)(p.og + ((size_t)1 * TC + row) * 512 + chk * 8);
    st.rc[i] = *(const U4*)(p.og + ((size_t)2 * TC + row) * 512 + chk * 8);
    st.rg[i] = *(const U4*)(p.proj + paddr(row, CGA + chk * 8));
  }
}
__device__ __forceinline__ void comb_fin(const Params& p, int it, int t512, const CombSt& st) {
  const int chk = t512 & 63;
#pragma unroll
  for (int i = 0; i < 4; ++i) {
    const size_t row = (size_t)((it * 4 + i) * 512 + t512) >> 6;
    float m = fmaxf(st.l0[i], fmaxf(st.l1[i], st.l2[i]));
    float e0 = __expf(st.l0[i] - m), e1 = __expf(st.l1[i] - m), e2 = __expf(st.l2[i] - m);
    float inv = __builtin_amdgcn_rcpf(e0 + e1 + e2);
    e0 *= inv; e1 *= inv; e2 *= inv;
    float a[8], b[8], c[8], gt[8], o[8];
    unpack8(st.ra[i], a); unpack8(st.rb[i], b); unpack8(st.rc[i], c); unpack8(st.rg[i], gt);
#pragma unroll
    for (int e = 0; e < 8; ++e) o[e] = (e0 * a[e] + e1 * b[e] + e2 * c[e]) * silu_f(gt[e]);
    *(U4*)(p.yattn + row * 512 + chk * 8) = pack8(o);
  }
}
__device__ __forceinline__ void res_load(const Params& p, int layer, int ch, int it, int t512, ResSt& st) {
  const int lane = t512 & 63, w = t512 >> 6;
  const int rl = it * 8 + w;
  const size_t rg = (size_t)ch * TC + rl;
  const float* xs = (layer == 0 ? p.x : p.out) + rg * D_;
  const float* wp = p.norm_post + layer * D_;
#pragma unroll
  for (int i = 0; i < 4; ++i) {
    int c = (i * 64 + lane) * 4;
    U2 pa = *(const U2*)(p.outA + (size_t)rl * D_ + c);
    st.xv[i] = *(const f32x4*)(xs + c);
    st.wv[i] = *(const f32x4*)(wp + c);
    st.o[i].x = lo2f(pa.x); st.o[i].y = hi2f(pa.x); st.o[i].z = lo2f(pa.y); st.o[i].w = hi2f(pa.y);
  }
}
__device__ __forceinline__ void res_fin(const Params& p, int layer, int ch, int it, int t512, const ResSt& st) {
  const int lane = t512 & 63, w = t512 >> 6;
  const int rl = it * 8 + w;
  const size_t rg = (size_t)ch * TC + rl;
  float* xd = p.out + rg * D_;
  float ps = 0.f;
#pragma unroll
  for (int i = 0; i < 4; ++i) ps += st.o[i].x * st.o[i].x + st.o[i].y * st.o[i].y + st.o[i].z * st.o[i].z + st.o[i].w * st.o[i].w;
  ps = wave_sum(ps);
  const float rstd = rsqrtf(ps * (1.f / D_) + EPS);
  f32x4 v[4];
  float ss = 0.f;
#pragma unroll
  for (int i = 0; i < 4; ++i) {
    int c = (i * 64 + lane) * 4;
    v[i] = st.xv[i] + st.o[i] * rstd * st.wv[i];
    *(f32x4*)(xd + c) = v[i];
    ss += v[i].x * v[i].x + v[i].y * v[i].y + v[i].z * v[i].z + v[i].w * v[i].w;
  }
  if (layer == 0) {
    ss = wave_sum(ss);
    float r2 = rsqrtf(ss * (1.f / D_) + EPS);
#pragma unroll
    for (int i = 0; i < 4; ++i) {
      U2 ov;
      ov.x = pack2(v[i].x * r2, v[i].y * r2);
      ov.y = pack2(v[i].z * r2, v[i].w * r2);
      *(U2*)(p.h + rg * D_ + (i * 64 + lane) * 4) = ov;
    }
  }
}

__device__ __forceinline__ void do_phase(const Params& p, int ph, int layer, int ch, char* smem0, int dup = 0) {
  const int G = gridDim.x, b0 = blockIdx.x;
  const int half_ = __builtin_amdgcn_readfirstlane(otid512() >> 8);
  char* smem = smem0 + half_ * HSMEM;
  if (ph == 0) {
    phase_weights(p, smem0);
  } else if (ph == 1) {
    pg8::Sched S; pg8::Epi E;
    E.O16 = p.proj; E.ld16 = NP; E.T16 = p.proj; E.ldt = NP; E.gate = p.proj; E.ldg = NP;
    S.kind = 0; S.so.init(TC, NP, G, b0); S.n = 0; S.mode0 = 0;
    S.gA = (const char*)(p.h + (size_t)ch * TC * D_); S.gB = (const char*)(p.WinT + (size_t)layer * NP * D_);
    S.tstep = (size_t)256 * D_ * 2;
    S.u0.pm = 0; S.u0.pn = 0; S.u0.a = S.gA; S.u0.b = S.gB; S.u0.mode = 0; S.u0.gcol = 0; S.u1 = S.u0;
    __syncthreads();
    pg8::gemm_phase((LAS unsigned char*)smem0, D_, S, E);
    {
      const int idx = layer * NCH + ch;
      constexpr int NWG = (TC / 256) * (NP / 256);
      const int nlong = NWG % G;
      if (idx > 0 && b0 >= nlong) {
        const int pl = (idx - 1) / NCH, pc = (idx - 1) % NCH;
        for (int it = b0 - nlong; it < NR1; it += G - nlong) resid_item(p, pl, pc, it);
      }
    }
  } else if (ph == 2) {
    constexpr int NA = NB * 32 * 4 * 2 / 2, NATT = NB * 8 * 3 * 32 / 2, NSC = TC * 64 / 2048;
    for (int sl = b0; sl < NA; sl += G) ssd_passA(p, layer, 2 * sl + half_, smem);
    {
      U4 kreg[8], vreg[8];
      int sl = (b0 + G - (NA % G)) % G;
      if (sl < NATT) attn_load(p, 2 * sl + half_, otid(), kreg, vreg);
      for (; sl < NATT; sl += G) {
        const int nx = sl + G;
        attn_item(p, 2 * sl + half_, nx < NATT ? 2 * nx + half_ : -1, kreg, vreg, smem);
      }
    }
    for (int it = (b0 + G - ((NA + NATT) % G)) % G; it < NSC; it += G) shortconv_item(p, layer, it);
  } else if (ph == 3) {
    constexpr int NS = NB * 16 * 4096 / 512, NCMB = TC * 64 / 2048;
    const int idx = layer * NCH + ch;
    const int pl = idx > 0 ? (idx - 1) / NCH : 0, pc = idx > 0 ? (idx - 1) % NCH : 0;
    const int t512 = otid512();
    for (int k = b0; k < NS || k < NCMB || (idx > 0 && NR1 + k < TC / 8); k += G) {
      const bool hs = k < NS, hc = k < NCMB, hr = idx > 0 && (NR1 + k) < TC / 8;
      ScanSt ss; CombSt cs; ResSt rs;
      if (hs) scan_load(p, k, t512, ss);
      if (hc) comb_load(p, k, t512, cs);
      if (hr) res_load(p, pl, pc, NR1 + k, t512, rs);
      if (hs) scan_fin(p, k, t512, ss);
      if (hc) comb_fin(p, k, t512, cs);
      if (hr) res_fin(p, pl, pc, NR1 + k, t512, rs);
    }
  } else if (ph == 4) {
    for (int sl = b0; sl < NB * 32 * 4 * 2 / 2; sl += G) ssd_passC(p, layer, 2 * sl + half_, smem);
  } else if (ph == 5) {
    for (int it = b0; it < (TC / 256) * 8; it += G) merge_tile8(p, layer, it, smem0);
  } else if (ph == 6) {
    for (int it = b0; it < (TC / 256) * 8; it += G) wout_tile8(p, layer, it, smem0);
  } else {
    for (int it = b0; it < TC / 8; it += G) resid_item(p, 1, NCH - 1, it);
  }
}

#define XB_TMO      128
#define XB_XCNT(j)  (256  + 64 * (j))
#define XB_XSUB(j)  (1280 + 64 * (j))
#define XB_XGEN(j)  (2304 + 64 * (j))
#define XB_TOP      3328
#define XB_TOPGEN   3392
#define XCD_BAR_WORDS 3456
#define XB_SPIN_CAP (1u << 20)
__device__ __forceinline__ unsigned xb_ld(unsigned* p) { return __hip_atomic_load(p, __ATOMIC_RELAXED, __HIP_MEMORY_SCOPE_AGENT); }
__device__ __forceinline__ unsigned xb_add(unsigned* p, unsigned v) { return __hip_atomic_fetch_add(p, v, __ATOMIC_RELAXED, __HIP_MEMORY_SCOPE_AGENT); }
__device__ __forceinline__ unsigned xb_xcc_id() { return (unsigned)__builtin_amdgcn_s_getreg((3 << 11) | 20) & 0xFu; }
#define XB_SPIN(cond, bar) do { unsigned _sp = 0; while (cond) { __builtin_amdgcn_s_sleep(1); \
    if ((++_sp & 255u) == 0u) { if (xb_ld(&(bar)[XB_TMO])) break; if (_sp > XB_SPIN_CAP) { atomicAdd(&(bar)[XB_TMO], 1u); break; } } } } while (0)
struct XcdBarrier { unsigned* bar; unsigned x; volatile LAS unsigned* st; };
__device__ __forceinline__ XcdBarrier xcd_barrier_post(unsigned* bar, volatile LAS unsigned* st) {
  XcdBarrier b; b.bar = bar; b.x = xb_xcc_id(); b.st = st;
  if (threadIdx.x == 0) (void)xb_add(&bar[XB_XCNT(b.x)], 1u);
  return b;
}
__device__ __forceinline__ void xcd_barrier_complete(unsigned* bar, unsigned x, unsigned& nloc, unsigned& nx) {
  const unsigned G = gridDim.x * gridDim.y * gridDim.z;
  unsigned sum, cnt, mine, sp = 0u;
  for (;;) {
    sum = 0u; cnt = 0u; mine = 0u;
#pragma unroll
    for (unsigned j = 0; j < 16; ++j) { const unsigned c = xb_ld(&bar[XB_XCNT(j)]); sum += c; cnt += (c > 0u) ? 1u : 0u; mine = (j == x) ? c : mine; }
    if (sum == G) break;
    __builtin_amdgcn_s_sleep(1);
    if ((++sp & 255u) == 0u) { if (xb_ld(&bar[XB_TMO])) break; if (sp > XB_SPIN_CAP) { atomicAdd(&bar[XB_TMO], 1u); break; } }
  }
  nloc = mine > 0u ? mine : 1u; nx = cnt > 0u ? cnt : 1u;
}
__device__ __forceinline__ void xcd_barrier(const XcdBarrier& b) {
  asm volatile("s_waitcnt vmcnt(0)" ::: "memory");
  __syncthreads();
  if (threadIdx.x == 0) {
    unsigned* bar = b.bar;
    __builtin_amdgcn_s_waitcnt(0);
    unsigned nloc = b.st[0], nx = b.st[1];
    if (nloc == 0u) { xcd_barrier_complete(bar, b.x, nloc, nx); b.st[0] = nloc; b.st[1] = nx; }
    const unsigned old = xb_add(&bar[XB_XSUB(b.x)], 1u);
    const unsigned gen = old / nloc;
    if (old + 1u == (gen + 1u) * nloc) {
      __builtin_amdgcn_fence(__ATOMIC_RELEASE, "agent");
      asm volatile("s_waitcnt vmcnt(0)" ::: "memory");
      const unsigned og = xb_add(&bar[XB_TOP], 1u);
      const unsigned tg = og / nx;
      if (og + 1u == (tg + 1u) * nx) xb_add(&bar[XB_TOPGEN], 1u);
      else XB_SPIN(xb_ld(&bar[XB_TOPGEN]) == tg, bar);
      __builtin_amdgcn_fence(__ATOMIC_ACQUIRE, "agent");
      xb_add(&bar[XB_XGEN(b.x)], 1u);
      asm volatile("s_waitcnt vmcnt(0)" ::: "memory");
    } else {
      XB_SPIN(xb_ld(&bar[XB_XGEN(b.x)]) == gen, bar);
      __builtin_amdgcn_fence(__ATOMIC_ACQUIRE, "agent");
      asm volatile("s_waitcnt vmcnt(0)" ::: "memory");
    }
  }
  __syncthreads();
}

#if COOP
__global__ void __launch_bounds__(512, 2) mega_kernel(Params p) {
  extern __shared__ __attribute__((aligned(16))) char smem[];
  cg::grid_group grid = cg::this_grid();
#ifdef ONLY_PH
  do_phase(p, ONLY_PH, 0, 1, smem); return;
#endif
  constexpr int NSTEP = 2 + 2 * NCH * 6;
  volatile LAS unsigned* st = (volatile LAS unsigned*)(LAS unsigned char*)(smem + SMEM_BYTES);
  if (threadIdx.x < 4) st[threadIdx.x] = 0u;
  if (blockIdx.x == 0) for (int i = threadIdx.x; i < XCD_BAR_WORDS; i += 512) p.bar[i] = 0u;
  __syncthreads();
  XcdBarrier xb;
#pragma unroll 1
  for (int step = 0; step < NSTEP; ++step) {
    int ph, layer, ch;
    if (step == 0) { ph = 0; layer = 0; ch = 0; }
    else if (step == NSTEP - 1) { ph = 7; layer = 1; ch = NCH - 1; }
    else {
      int s1 = step - 1;
      ph = 1 + s1 % 6;
      int it = s1 / 6;
      layer = it / NCH; ch = it % NCH;
    }
    do_phase(p, ph, layer, ch, smem);
#ifdef DUP_PH
    if (ph == DUP_PH) { xcd_barrier(xb); do_phase(p, ph, layer, ch, smem, 1); }
#endif
    if (step == 0) {
      grid.sync();
      xb = xcd_barrier_post(p.bar, st);
    } else if (step != NSTEP - 1) {
      xcd_barrier(xb);
    }
  }
}
#else
__global__ void __launch_bounds__(512, 2) phase_kernel(Params p, int ph, int layer, int ch) {
  extern __shared__ __attribute__((aligned(16))) char smem[];
  do_phase(p, ph, layer, ch, smem);
}
#endif

extern "C" void kernel_launch(void* const* d_in, const int* in_sizes, int n_in, void* d_out, int out_size, void* d_ws,
                              size_t ws_size, hipStream_t stream) {
  Params p{};
  p.x = (const float*)d_in[0]; p.norm_pre = (const float*)d_in[1]; p.norm_post = (const float*)d_in[2];
  p.w_in = (const float*)d_in[3]; p.ssm_conv_w = (const float*)d_in[4]; p.ssm_conv_b = (const float*)d_in[5];
  p.dt_bias = (const float*)d_in[6]; p.a_log = (const float*)d_in[7]; p.d_skip = (const float*)d_in[8];
  p.ssm_norm = (const float*)d_in[9]; p.sc_conv_w = (const float*)d_in[10]; p.p_ssm = (const float*)d_in[11];
  p.p_attn = (const float*)d_in[12]; p.p_sc = (const float*)d_in[13]; p.w_out = (const float*)d_in[14];
  p.out = (float*)d_out;
  char* ws = (char*)d_ws;
  size_t off = 0;
  auto take = [&](size_t bytes) { char* r = ws + off; off += (bytes + 255) & ~(size_t)255; return r; };
  p.WinT = (u16*)take((size_t)2 * NP * D_ * 2);
  p.PsT = (u16*)take((size_t)2 * 1024 * 1024 * 2);
  p.PaT = (u16*)take((size_t)2 * 1024 * 512 * 2);
  p.PcT = (u16*)take((size_t)2 * 1024 * 512 * 2);
  p.WoT = (u16*)take((size_t)2 * 1024 * 1024 * 2);
  p.h = (u16*)take((size_t)T_ * D_ * 2);
  p.proj = (u16*)take((size_t)TC * NP * 2);
  p.xc = (u16*)take((size_t)TC * 2048 * 2);
  p.xT = (u16*)take((size_t)NB * 32 * 16 * 8192 * 2);
  p.prev = (u16*)take((size_t)NB * 32 * 16 * 8192 * 2);
  p.og = (u16*)take((size_t)3 * TC * 512 * 2);
  p.yattn = (u16*)take((size_t)TC * 512 * 2);
  p.ysc = (u16*)take((size_t)TC * 512 * 2);
  p.yssm = (u16*)take((size_t)TC * 1024 * 2);
  p.Pa = (u16*)take((size_t)TC * 1024 * 2);
  p.Pb = p.og;
  p.stloc = (u16*)take((size_t)NB * 32 * 16 * 8192 * 2);
  p.outA = (u16*)take((size_t)TC * 1024 * 2);
  p.outB = p.xc;
  p.dec = (float*)take((size_t)NB * 32 * 16 * 4);
  p.lse = (float*)take((size_t)3 * TC * 8 * 4);
  p.bar = (unsigned*)take((size_t)XCD_BAR_WORDS * 4);
  if (off > ws_size) fprintf(stderr, "workspace too small: need %zu have %zu\n", off, ws_size);
#if COOP
  static int grid_blocks = 0;
  if (!grid_blocks) {
    int dev = 0, cus = 0, per_cu = 0;
    hipGetDevice(&dev);
    hipDeviceGetAttribute(&cus, hipDeviceAttributeMultiprocessorCount, dev);
    hipFuncSetAttribute((const void*)mega_kernel, hipFuncAttributeMaxDynamicSharedMemorySize, SMEM_BYTES + 16);
    hipOccupancyMaxActiveBlocksPerMultiprocessor(&per_cu, mega_kernel, 512, SMEM_BYTES + 16);
    if (per_cu > 1) per_cu = 1;
    grid_blocks = cus * per_cu;
  }
  void* args[] = {&p};
  hipError_t e = hipLaunchCooperativeKernel((void*)mega_kernel, dim3(grid_blocks), dim3(512), args, SMEM_BYTES + 16, stream);
  if (e != hipSuccess) fprintf(stderr, "cooperative launch failed: %s (grid %d)\n", hipGetErrorString(e), grid_blocks);
#else
  const int grid = 256;
  hipFuncSetAttribute((const void*)phase_kernel, hipFuncAttributeMaxDynamicSharedMemorySize, SMEM_BYTES);
  phase_kernel<<<grid, 512, SMEM_BYTES, stream>>>(p, 0, 0, 0);
  for (int layer = 0; layer < 2; ++layer)
    for (int ch = 0; ch < NCH; ++ch)
      for (int ph = 1; ph <= 6; ++ph) phase_kernel<<<grid, 512, SMEM_BYTES, stream>>>(p, ph, layer, ch);
  phase_kernel<<<grid, 512, SMEM_BYTES, stream>>>(p, 7, 1, NCH - 1);
#endif
}
```
